# Optimizing an MI355X kernel written in HIP

```python
import math
import jax, jax.numpy as jnp
from jax import lax
import numpy as np

D_MODEL = 1024
BATCH = 2
SEQ = 8192
DEPTH = 1

CHUNK = 64
D_MIX = D_MODEL
GM_GROUPS = 8
GM_GROUP_DIM = 64
GM_WIDTH = GM_GROUPS * GM_GROUP_DIM
GM_BLOCK = 128
DN_HEADS = 4
DN_HEAD_DIM = 128
DN_WIDTH = DN_HEADS * DN_HEAD_DIM
DN_CONV = 4
D_IN = 2 * GM_WIDTH + 4 * DN_WIDTH + 2 * DN_HEADS
D_FF = 2816
EPS = 1e-6

kernel_name = "hybrid_gmlp_gated_deltanet_macaron"


def rmsnorm(x, g):
    xf = x.astype(jnp.float32)
    y = xf * lax.rsqrt(jnp.mean(xf * xf, axis=-1, keepdims=True) + EPS)
    return (y * g.astype(jnp.float32)).astype(x.dtype)


def layernorm(x, g, b):
    xf = x.astype(jnp.float32)
    mu = jnp.mean(xf, axis=-1, keepdims=True)
    var = jnp.mean(jnp.square(xf - mu), axis=-1, keepdims=True)
    y = (xf - mu) * lax.rsqrt(var + EPS)
    return (y * g.astype(jnp.float32) + b.astype(jnp.float32)).astype(x.dtype)


def l2norm(x):
    return x * lax.rsqrt(jnp.sum(x * x, axis=-1, keepdims=True) + EPS)


def swiglu(x, w_gate, w_up, w_down):
    return (jax.nn.silu(x @ w_gate) * (x @ w_up)) @ w_down


def chunk_causal_mask(n):
    c = jnp.arange(n) // CHUNK
    return c[None, :] <= c[:, None]


def spatial_gating(u, v, w_s, b_s, ln_g, ln_b):
    B, T, _ = v.shape
    v = layernorm(v, ln_g, ln_b)
    nb = T // GM_BLOCK
    vb = v.reshape(B, nb, GM_BLOCK, GM_GROUPS, GM_GROUP_DIM)
    w = jnp.where(chunk_causal_mask(GM_BLOCK)[None], w_s, 0.0).astype(v.dtype)
    mixed = jnp.einsum('gij,bnjgc->bnigc', w, vb) + b_s.T[:, :, None].astype(v.dtype)
    return u * mixed.reshape(B, T, GM_WIDTH)


def causal_dwconv(x, w):
    K, C = w.shape
    return lax.conv_general_dilated(
        x, w[:, None, :].astype(x.dtype), window_strides=(1,), padding=[(K - 1, 0)],
        dimension_numbers=('NWC', 'WIO', 'NWC'), feature_group_count=C)


def gated_delta_rule(q, k, v, beta, g):
    B, T, H, Dk = q.shape
    Dv = v.shape[-1]
    C = CHUNK
    N = T // C
    scale = Dk ** -0.5

    def to_chunks(t):
        return t.reshape(B, N, C, H, *t.shape[3:]).swapaxes(2, 3)

    q, k, v = to_chunks(q * scale), to_chunks(k), to_chunks(v)
    beta, g = to_chunks(beta), to_chunks(g)
    g = jnp.cumsum(g, axis=-1)
    tri = jnp.tril(jnp.ones((C, C), bool))
    strict = jnp.tril(jnp.ones((C, C), bool), -1)
    decay = jnp.exp(jnp.where(tri, g[..., :, None] - g[..., None, :], -jnp.inf))
    k_beta = k * beta[..., None]
    v_beta = v * beta[..., None]
    L = jnp.where(strict, jnp.einsum('bnhid,bnhjd->bnhij', k_beta, k) * decay, 0.0)
    eye = jnp.eye(C, dtype=L.dtype)
    rhs = jnp.concatenate([v_beta, k_beta * jnp.exp(g)[..., None]], axis=-1)
    sol = lax.linalg.triangular_solve(L + eye, rhs, left_side=True, lower=True,
                                      unit_diagonal=True)
    u_c, w_c = sol[..., :Dv], sol[..., Dv:]
    attn = jnp.where(tri, jnp.einsum('bnhid,bnhjd->bnhij', q, k) * decay, 0.0)
    g_last = g[..., -1]
    k_dec = k * jnp.exp(g_last[..., None] - g)[..., None]
    q_dec = q * jnp.exp(g)[..., None]
    xs = tuple(jnp.moveaxis(t, 1, 0) for t in (q_dec, k_dec, u_c, w_c, attn, g_last))

    def step(S, inp):
        qd, kd, uc, wc, a, gl = inp
        v_new = uc - jnp.einsum('bhcd,bhde->bhce', wc, S)
        o = jnp.einsum('bhcd,bhde->bhce', qd, S) + jnp.einsum('bhij,bhje->bhie', a, v_new)
        S = S * jnp.exp(gl)[..., None, None] + jnp.einsum('bhcd,bhce->bhde', kd, v_new)
        return S, o

    S0 = jnp.zeros((B, H, Dk, Dv), q.dtype)
    _, o = lax.scan(step, S0, xs)
    return jnp.moveaxis(o, 0, 1).swapaxes(2, 3).reshape(B, T, H, Dv)


def setup_inputs(seed: int = 0) -> dict:
    key = jax.random.key(seed)
    ks = jax.random.split(key, 24)
    f32 = jnp.float32
    L = DEPTH

    def nrm(k, shape, scale):
        return jax.random.normal(k, shape, f32) * scale

    def gain(k, shape):
        return 1.0 + 0.05 * jax.random.normal(k, shape, f32)

    dt = jnp.exp(jax.random.uniform(ks[13], (L, DN_HEADS), f32, math.log(1e-3), math.log(1e-1)))
    return {
        "x": jax.random.normal(ks[0], (BATCH, SEQ, D_MODEL), f32),
        "ffn1_norm": gain(ks[1], (L, D_MODEL)),
        "ffn1_w_gate": nrm(ks[2], (L, D_MODEL, D_FF), D_MODEL ** -0.5),
        "ffn1_w_up": nrm(ks[3], (L, D_MODEL, D_FF), D_MODEL ** -0.5),
        "ffn1_w_down": nrm(ks[4], (L, D_FF, D_MODEL), D_FF ** -0.5),
        "mix_norm": gain(ks[5], (L, D_MODEL)),
        "w_in": nrm(ks[6], (L, D_MODEL, D_IN), D_MODEL ** -0.5),
        "gm_ln_g": gain(ks[7], (L, GM_WIDTH)),
        "gm_ln_b": nrm(ks[8], (L, GM_WIDTH), 0.02),
        "gm_w_s": nrm(ks[9], (L, GM_GROUPS, GM_BLOCK, GM_BLOCK), GM_BLOCK ** -0.5),
        "gm_b_s": 1.0 + nrm(ks[10], (L, GM_GROUPS, GM_BLOCK), 0.1),
        "dn_conv_w": nrm(ks[11], (L, DN_CONV, 3 * DN_WIDTH), DN_CONV ** -0.5),
        "dn_a_log": jnp.log(jax.random.uniform(ks[12], (L, DN_HEADS), f32, 1.0, 16.0)),
        "dn_dt_bias": dt + jnp.log(-jnp.expm1(-dt)),
        "dn_norm": gain(ks[14], (L, DN_HEAD_DIM)),
        "w_out": nrm(ks[15], (L, D_MIX, D_MODEL), D_MIX ** -0.5),
        "ffn2_norm": gain(ks[16], (L, D_MODEL)),
        "ffn2_w_gate": nrm(ks[17], (L, D_MODEL, D_FF), D_MODEL ** -0.5),
        "ffn2_w_up": nrm(ks[18], (L, D_MODEL, D_FF), D_MODEL ** -0.5),
        "ffn2_w_down": nrm(ks[19], (L, D_FF, D_MODEL), D_FF ** -0.5),
        "final_norm": gain(ks[20], (D_MODEL,)),
    }


def reference(x, ffn1_norm, ffn1_w_gate, ffn1_w_up, ffn1_w_down, mix_norm, w_in,
              gm_ln_g, gm_ln_b, gm_w_s, gm_b_s, dn_conv_w, dn_a_log, dn_dt_bias, dn_norm,
              w_out, ffn2_norm, ffn2_w_gate, ffn2_w_up, ffn2_w_down, final_norm):
    B, T, _ = x.shape
    split_at = [GM_WIDTH, 2 * GM_WIDTH, 2 * GM_WIDTH + 3 * DN_WIDTH,
                2 * GM_WIDTH + 4 * DN_WIDTH, 2 * GM_WIDTH + 4 * DN_WIDTH + DN_HEADS]
    for l in range(DEPTH):
        x = x + 0.5 * swiglu(rmsnorm(x, ffn1_norm[l]), ffn1_w_gate[l], ffn1_w_up[l], ffn1_w_down[l])

        h = rmsnorm(x, mix_norm[l])
        p = h @ w_in[l]
        u_a, v_a, qkv, z, b_raw, a_raw = jnp.split(p, split_at, axis=-1)

        y_a = spatial_gating(jax.nn.gelu(u_a), jax.nn.gelu(v_a), gm_w_s[l], gm_b_s[l],
                             gm_ln_g[l], gm_ln_b[l])

        qkv = jax.nn.silu(causal_dwconv(qkv, dn_conv_w[l])).astype(jnp.float32)
        q, k, v = jnp.split(qkv, 3, axis=-1)
        q = l2norm(q.reshape(B, T, DN_HEADS, DN_HEAD_DIM))
        k = l2norm(k.reshape(B, T, DN_HEADS, DN_HEAD_DIM))
        v = v.reshape(B, T, DN_HEADS, DN_HEAD_DIM)
        beta = jax.nn.sigmoid(b_raw.astype(jnp.float32))
        g = -jnp.exp(dn_a_log[l].astype(jnp.float32)) * jax.nn.softplus(
            a_raw.astype(jnp.float32) + dn_dt_bias[l].astype(jnp.float32))
        o = gated_delta_rule(q, k, v, beta, g)
        zg = jax.nn.silu(z.astype(jnp.float32)).reshape(B, T, DN_HEADS, DN_HEAD_DIM)
        y_b = (rmsnorm(o, dn_norm[l]) * zg).reshape(B, T, DN_WIDTH).astype(x.dtype)

        x = x + jnp.concatenate([y_a, y_b], axis=-1) @ w_out[l]

        x = x + 0.5 * swiglu(rmsnorm(x, ffn2_norm[l]), ffn2_w_gate[l], ffn2_w_up[l], ffn2_w_down[l])
    return rmsnorm(x, final_norm)
```

```cpp
#include <hip/hip_runtime.h>
#include <hip/hip_cooperative_groups.h>
#include <cstdio>
#include <cstdint>
namespace cg = cooperative_groups;
namespace pg8 {
#define PG8_LAS __attribute__((address_space(3)))
typedef unsigned short bf16_t;
typedef short bf16x8 __attribute__((ext_vector_type(8)));
typedef float f32x4 __attribute__((ext_vector_type(4)));
typedef unsigned u32x4 __attribute__((ext_vector_type(4)));
constexpr int BM = 256, BK = 64, HALF = 128, HTB = HALF * BK * 2  , STAGE_BYTES = 8 * HTB, NXCD = 8, WGM = 8;

__host__ __device__ __forceinline__ int lds_byte(int r, int c) { const int st = (r >> 4) * 2 + (c >> 5), rr = r & 15, cc = c & 31, ob = rr * 64 + cc * 2; return st * 1024 + (ob ^ (((ob >> 9) & 1) << 5)); }
__host__ __device__ __forceinline__ void stage_rc(int b, int& R, int& C) { const int st = b / 1024, sb = b % 1024, swz = sb ^ (((sb >> 9) & 1) << 5); R = (st >> 1) * 16 + swz / 64; C = (st & 1) * 32 + (swz % 64) / 2; }
__host__ __device__ __forceinline__ int perm32(int rho) { const int n = rho >> 4, i = rho & 15; return 8 * (i >> 2) + 4 * n + (i & 3); }

struct Unit { int pm, pn; };
struct Gemm { const bf16_t* A; const bf16_t* Bt; int M, N, K; };

struct StaticOrder {
    int nM, nN, nwg, G, c;
    __host__ __device__ void init(int M, int N, int G_, int c_) { nM = M / BM; nN = N / BM; nwg = nM * nN; G = G_; c = c_; }
    __host__ __device__ bool next(int i, Unit& u) const {
        const long L = (long)i * G + c; if (L >= nwg) return false;
        int wgid = (int)L; { const int q = nwg / NXCD, r = nwg % NXCD, xcd = wgid % NXCD, off = wgid / NXCD; wgid = (xcd < r ? xcd * (q + 1) : r * (q + 1) + (xcd - r) * q) + off; }
        const int nig = WGM * nN, gid = wgid / nig, fm = gid * WGM, gsz = (nM - fm) < WGM ? (nM - fm) : WGM;
        u.pm = fm + ((wgid % nig) % gsz); u.pn = (wgid % nig) / gsz; return true;
    }
    __device__ __forceinline__ void a_ready(const Unit&) const {}
    __device__ __forceinline__ void done(const Unit&) const {}
};

__device__ __forceinline__ unsigned cvt_pk_bf16(float lo, float hi) { unsigned r; asm volatile("v_cvt_pk_bf16_f32 %0, %1, %2" : "=v"(r) : "v"(lo), "v"(hi)); return r; }

template <class Epi, class Sched, bool ALIGN_EPI = false, bool SP2 = false>
__device__ __forceinline__ void gemm_phase(PG8_LAS unsigned char* lds, const Gemm g, const Sched& S, const Epi& E) {
    const int tid = threadIdx.x, wid = __builtin_amdgcn_readfirstlane(tid >> 6), lane = tid & 63, wr = wid >> 2, wc = wid & 3, fr = lane & 15, fq = lane >> 4;
    const int K = g.K, nt = K / BK;
    unsigned voffA[2], voffB[2];
#pragma unroll
    for (int i = 0; i < 2; ++i) { int R, C; stage_rc(tid * 16 + i * 8192, R, C); const int Rb = Epi::PERM ? ((R & ~31) + perm32(R & 31)) : R;
        voffA[i] = (unsigned)(R * K + C) * 2u; voffB[i] = (unsigned)(Rb * K + C) * 2u; }
    const size_t kstep = (size_t)(BK * 2);
    const size_t hstep = (size_t)HALF * K * 2;
    const size_t tstep = 2 * hstep;
    const unsigned ldsw = (unsigned)wid * 1024u;
    const int aoff = lds_byte(wr * 64 + fr, fq * 8), boff = lds_byte(wc * 32 + fr, fq * 8);
#define PG8_SA(b, h) (((b) * 2 + (h)) * HTB)
#define PG8_SB(b, h) ((4 + (b) * 2 + (h)) * HTB)
#define PG8_STAGE(bufoff, gbase, voff) do { _Pragma("unroll") for (int _i = 0; _i < 2; ++_i) \
        __builtin_amdgcn_global_load_lds((const unsigned*)((const char*)(gbase) + (voff)[_i]), (PG8_LAS unsigned*)(lds + (bufoff) + ldsw + _i * 8192), 16, 0, 0); } while (0)
#define PG8_LDA(dst, b, h) do { _Pragma("unroll") for (int m = 0; m < 4; ++m) _Pragma("unroll") for (int k = 0; k < 2; ++k) dst[m][k] = *(const PG8_LAS bf16x8*)(lds + PG8_SA(b, h) + aoff + m * 2048 + k * 1024); } while (0)
#define PG8_LDB(dst, b, h) do { _Pragma("unroll") for (int n = 0; n < 2; ++n) _Pragma("unroll") for (int k = 0; k < 2; ++k) dst[n][k] = *(const PG8_LAS bf16x8*)(lds + PG8_SB(b, h) + boff + n * 2048 + k * 1024); } while (0)
#define PG8_MMA(ai, bj, At, Bt) do { __builtin_amdgcn_s_setprio(1); _Pragma("unroll") for (int m = 0; m < 4; ++m) _Pragma("unroll") for (int n = 0; n < 2; ++n) _Pragma("unroll") for (int k = 0; k < 2; ++k) \
        acc[ai][bj][m][n] = __builtin_amdgcn_mfma_f32_16x16x32_bf16(Bt[n][k], At[m][k], acc[ai][bj][m][n], 0, 0, 0); __builtin_amdgcn_s_setprio(0); } while (0)
#define PG8_WAIT_V(n) asm volatile("s_waitcnt vmcnt(" #n ")" ::: "memory")
#define PG8_WAIT_L(n) asm volatile("s_waitcnt lgkmcnt(" #n ")" ::: "memory")
#define PG8_BAR __builtin_amdgcn_s_barrier()
#define PG8_SCHED __builtin_amdgcn_sched_barrier(0)
    Unit cur, nxt; int ui = 0;
    if (!S.next(0, cur)) return;
    f32x4 acc[2][2][4][2];
#pragma unroll
    for (int a = 0; a < 2; ++a)
#pragma unroll
        for (int b = 0; b < 2; ++b)
#pragma unroll
            for (int m = 0; m < 4; ++m)
#pragma unroll
                for (int n = 0; n < 2; ++n) acc[a][b][m][n] = (f32x4){0.f, 0.f, 0.f, 0.f};
    bf16x8 At[4][2], B0[2][2], B1[2][2];
    const char* cA = (const char*)g.A + (size_t)cur.pm * tstep; const char* cB = (const char*)g.Bt + (size_t)cur.pn * tstep;
    S.a_ready(cur);
    if constexpr (SP2) {
        PG8_STAGE(PG8_SB(0, 0), cB, voffB); PG8_STAGE(PG8_SB(0, 1), cB + hstep, voffB); PG8_STAGE(PG8_SA(0, 0), cA, voffA); PG8_STAGE(PG8_SA(0, 1), cA + hstep, voffA);
        if (wr == 1) PG8_BAR;
        PG8_WAIT_V(2); PG8_BAR;
        PG8_STAGE(PG8_SB(1, 0), cB + kstep, voffB); PG8_STAGE(PG8_SA(1, 0), cA + kstep, voffA); PG8_STAGE(PG8_SB(1, 1), cB + hstep + kstep, voffB);
        PG8_WAIT_V(6); PG8_BAR;
    } else {
        PG8_STAGE(PG8_SB(0, 0), cB, voffB); PG8_STAGE(PG8_SA(0, 0), cA, voffA); PG8_STAGE(PG8_SB(0, 1), cB + hstep, voffB); PG8_STAGE(PG8_SA(0, 1), cA + hstep, voffA);
        if (wr == 1) PG8_BAR;
        PG8_WAIT_V(4); PG8_BAR;
        PG8_STAGE(PG8_SB(1, 0), cB + kstep, voffB); PG8_STAGE(PG8_SA(1, 0), cA + kstep, voffA); PG8_STAGE(PG8_SB(1, 1), cB + hstep + kstep, voffB);
        PG8_WAIT_V(6); PG8_BAR;
    }
    for (;;) {
        const bool has_next = S.next(ui + 1, nxt);
        const char* nA = has_next ? (const char*)g.A + (size_t)nxt.pm * tstep : cA; const char* nB = has_next ? (const char*)g.Bt + (size_t)nxt.pn * tstep : cB;
        for (int t = 0; t < nt; t += 2) {
            const bool last = (t == nt - 2);
            const char* a1 = cA + (size_t)(t + 1) * kstep;
            const char* a2 = last ? nA : cA + (size_t)(t + 2) * kstep; const char* b2 = last ? nB : cB + (size_t)(t + 2) * kstep;
            const char* a3 = a2 + kstep; const char* b3 = b2 + kstep;
            if (last && has_next) S.a_ready(nxt);
            if constexpr (SP2) {
            PG8_LDB(B0, 0, 0); PG8_LDB(B1, 0, 1); PG8_SCHED; PG8_LDA(At, 0, 0); PG8_STAGE(PG8_SA(1, 1), a1 + hstep, voffA);
            PG8_WAIT_V(8); PG8_WAIT_L(0); PG8_BAR; PG8_MMA(0, 0, At, B0); PG8_MMA(0, 1, At, B1); PG8_BAR; PG8_SCHED;
            PG8_LDA(At, 0, 1); PG8_STAGE(PG8_SB(0, 0), b2, voffB); PG8_STAGE(PG8_SB(0, 1), b2 + hstep, voffB); PG8_STAGE(PG8_SA(0, 0), a2, voffA);
            PG8_WAIT_V(8); PG8_WAIT_L(0); PG8_BAR; PG8_MMA(1, 0, At, B0); PG8_MMA(1, 1, At, B1); PG8_BAR; PG8_SCHED;
            PG8_LDB(B0, 1, 0); PG8_LDB(B1, 1, 1); PG8_SCHED; PG8_LDA(At, 1, 0); PG8_STAGE(PG8_SA(0, 1), a2 + hstep, voffA);
            PG8_WAIT_V(8); PG8_WAIT_L(0); PG8_BAR; PG8_MMA(0, 0, At, B0); PG8_MMA(0, 1, At, B1); PG8_BAR; PG8_SCHED;
            PG8_LDA(At, 1, 1); PG8_STAGE(PG8_SB(1, 0), b3, voffB); PG8_STAGE(PG8_SB(1, 1), b3 + hstep, voffB); PG8_STAGE(PG8_SA(1, 0), a3, voffA);
            PG8_WAIT_V(8); PG8_WAIT_L(0); PG8_BAR; PG8_MMA(1, 0, At, B0); PG8_MMA(1, 1, At, B1); PG8_BAR; PG8_SCHED;
            } else {
            PG8_LDB(B0, 0, 0); PG8_SCHED; PG8_LDA(At, 0, 0); PG8_STAGE(PG8_SA(1, 1), a1 + hstep, voffA);
            PG8_WAIT_L(8); PG8_BAR; PG8_WAIT_L(0); PG8_MMA(0, 0, At, B0); PG8_BAR; PG8_SCHED;
            PG8_LDB(B1, 0, 1); PG8_STAGE(PG8_SB(0, 0), b2, voffB);
            PG8_BAR; PG8_WAIT_L(0); PG8_MMA(0, 1, At, B1); PG8_BAR;
            PG8_LDA(At, 0, 1); PG8_STAGE(PG8_SA(0, 0), a2, voffA);
            PG8_BAR; PG8_WAIT_L(0); PG8_MMA(1, 0, At, B0); PG8_BAR; PG8_SCHED;
            PG8_STAGE(PG8_SB(0, 1), b2 + hstep, voffB);
            PG8_WAIT_V(6); PG8_BAR; PG8_MMA(1, 1, At, B1); PG8_BAR;
            PG8_LDB(B0, 1, 0); PG8_SCHED; PG8_LDA(At, 1, 0); PG8_STAGE(PG8_SA(0, 1), a2 + hstep, voffA);
            PG8_WAIT_L(8); PG8_BAR; PG8_WAIT_L(0); PG8_MMA(0, 0, At, B0); PG8_BAR; PG8_SCHED;
            PG8_LDB(B1, 1, 1); PG8_STAGE(PG8_SB(1, 0), b3, voffB);
            PG8_BAR; PG8_WAIT_L(0); PG8_MMA(0, 1, At, B1); PG8_BAR;
            PG8_LDA(At, 1, 1); PG8_STAGE(PG8_SA(1, 0), a3, voffA);
            PG8_BAR; PG8_WAIT_L(0); PG8_MMA(1, 0, At, B0); PG8_BAR; PG8_SCHED;
            PG8_STAGE(PG8_SB(1, 1), b3 + hstep, voffB);
            PG8_WAIT_V(6); PG8_BAR; PG8_MMA(1, 1, At, B1); PG8_BAR;
            }
        }
        if constexpr (ALIGN_EPI) { if (wr == 0) PG8_BAR; }
        if constexpr (!Epi::AFTER_DRAIN) { E(acc, cur, wr, wc, fr, fq); S.done(cur); }
        if (!has_next) break;
#pragma unroll
        for (int a = 0; a < 2; ++a)
#pragma unroll
            for (int b = 0; b < 2; ++b)
#pragma unroll
                for (int m = 0; m < 4; ++m)
#pragma unroll
                    for (int n = 0; n < 2; ++n) acc[a][b][m][n] = (f32x4){0.f, 0.f, 0.f, 0.f};
        cur = nxt; cA = nA; cB = nB; ++ui;
        if constexpr (ALIGN_EPI) { if (wr == 1) PG8_BAR; }
    }
    PG8_WAIT_V(0);
    if constexpr (!ALIGN_EPI) { if (wr == 0) PG8_BAR; }
    PG8_BAR;
    if constexpr (Epi::AFTER_DRAIN) { E.fused(acc, cur, wr, wc, fr, fq, lds, wid, lane); S.done(cur); }
#undef PG8_SA
#undef PG8_SB
#undef PG8_STAGE
#undef PG8_LDA
#undef PG8_LDB
#undef PG8_MMA
#undef PG8_WAIT_V
#undef PG8_WAIT_L
#undef PG8_BAR
#undef PG8_SCHED
}
}

#define LAS __attribute__((address_space(3)))
typedef unsigned short bf16;
typedef unsigned v4u __attribute__((ext_vector_type(4)));
typedef unsigned v2u __attribute__((ext_vector_type(2)));
typedef float f32x4 __attribute__((ext_vector_type(4)));
typedef float f32x16 __attribute__((ext_vector_type(16)));
typedef short bf16x8 __attribute__((ext_vector_type(8)));

constexpr int NWAVES = 8, NTHR = 512;
constexpr int BATCH = 2, T = 8192, D = 1024, M = BATCH * T, FF = 2816, NIN = 3072, DIN = 3080;
constexpr int NCH = T / 64, NITEM = BATCH * NCH * 4;
constexpr float EPS = 1e-6f;
constexpr size_t MiB = 1u << 20;
constexpr size_t WS_CTL = 0, CTL_ZERO_BYTES = 1 * MiB;
constexpr size_t WS_PCNT = 768 * 1024;
constexpr size_t WS_BAR = 512 * 1024;
constexpr size_t WS_WOUT = 1 * MiB, WS_WGU2 = 3 * MiB, WS_WD2 = 14 * MiB;
constexpr size_t WS_WEX = 19 * MiB + 512 * 1024, WS_GL = WS_WEX + 64 * 1024, WS_PEX = 20 * MiB;
constexpr size_t WS_WGU1 = 20 * MiB + 512 * 1024, WS_WD1 = 31 * MiB + 512 * 1024, WS_WIN = 37 * MiB;
constexpr size_t WS_XB = 44 * MiB;
constexpr size_t WS_MS = WS_XB;
constexpr size_t WS_H = 76 * MiB;
constexpr size_t WS_Y = 172 * MiB;
constexpr size_t WS_BS = 204 * MiB;
constexpr size_t WS_QP = 236 * MiB;
constexpr size_t WS_END = 252 * MiB;
constexpr int LDS_BYTES = 155648;

__device__ __forceinline__ float bf2f(unsigned short v) { return __uint_as_float(((unsigned)v) << 16); }
__device__ __forceinline__ float lo_bf(unsigned w) { return __uint_as_float(w << 16); }
__device__ __forceinline__ float hi_bf(unsigned w) { return __uint_as_float(w & 0xffff0000u); }
typedef float f32x2_t __attribute__((ext_vector_type(2)));
typedef __bf16 bf16x2_t __attribute__((ext_vector_type(2)));
__device__ __forceinline__ unsigned pk2(float lo, float hi) { const f32x2_t v = {lo, hi}; const bf16x2_t b = __builtin_convertvector(v, bf16x2_t); return __builtin_bit_cast(unsigned, b); }
__device__ __forceinline__ float sigm(float x) { return __builtin_amdgcn_rcpf(1.f + __expf(-x)); }
__device__ __forceinline__ float silu_(float x) { return x * sigm(x); }
__device__ __forceinline__ void sigm2(float x0, float x1, float& s0, float& s1) {
    const float a = 1.f + __expf(-fmaxf(x0, -30.f)), b = 1.f + __expf(-fmaxf(x1, -30.f)); const float r = __builtin_amdgcn_rcpf(a * b); s0 = b * r; s1 = a * r;
}
__device__ __forceinline__ float gelu_(float x) { const float u = 0.7978845608028654f * (x + 0.044715f * x * x * x); return x * sigm(2.f * u); }
__device__ __forceinline__ float wave_sum(float v) {
#pragma unroll
    for (int o = 1; o < 64; o <<= 1) v += __shfl_xor(v, o);
    return v;
}
#define LDS_WAIT() asm volatile("s_waitcnt lgkmcnt(0)" ::: "memory")
#define WG_BAR() do { asm volatile("s_waitcnt lgkmcnt(0)" ::: "memory"); __builtin_amdgcn_s_barrier(); asm volatile("" ::: "memory"); } while (0)

template <int KS> __device__ __forceinline__ void mm_lds(f32x16& acc, const LAS unsigned char* a, int aStride, const LAS unsigned char* b, int bStride, int lane) {
    const int r = lane & 31, h = lane >> 5;
    const LAS unsigned char* ap = a + r * aStride + h * 16; const LAS unsigned char* bp = b + r * bStride + h * 16;
    f32x16 acc2;
#pragma unroll
    for (int i = 0; i < 16; ++i) acc2[i] = 0.f;
#pragma unroll
    for (int ks = 0; ks < KS; ks += 2) {
        const bf16x8 av = *(const LAS bf16x8*)(ap + ks * 32); const bf16x8 bv = *(const LAS bf16x8*)(bp + ks * 32);
        const bf16x8 av1 = *(const LAS bf16x8*)(ap + (ks + 1) * 32); const bf16x8 bv1 = *(const LAS bf16x8*)(bp + (ks + 1) * 32);
        acc = __builtin_amdgcn_mfma_f32_32x32x16_bf16(av, bv, acc, 0, 0, 0);
        acc2 = __builtin_amdgcn_mfma_f32_32x32x16_bf16(av1, bv1, acc2, 0, 0, 0);
    }
#pragma unroll
    for (int i = 0; i < 16; ++i) acc[i] += acc2[i];
}
__device__ __forceinline__ f32x16 zero16() { f32x16 z;
#pragma unroll
    for (int i = 0; i < 16; ++i) z[i] = 0.f;
    return z; }


__device__ __forceinline__ void ans_pack(const f32x16& v, v4u& w0, v4u& w1) {
    w0.x = pk2(v[0], v[1]); w0.y = pk2(v[2], v[3]); w0.z = pk2(v[4], v[5]); w0.w = pk2(v[6], v[7]);
    w1.x = pk2(v[8], v[9]); w1.y = pk2(v[10], v[11]); w1.z = pk2(v[12], v[13]); w1.w = pk2(v[14], v[15]);
}
__device__ __forceinline__ void ans_unpack(const v4u& w0, const v4u& w1, f32x16& v) {
    v[0] = lo_bf(w0.x); v[1] = hi_bf(w0.x); v[2] = lo_bf(w0.y); v[3] = hi_bf(w0.y); v[4] = lo_bf(w0.z); v[5] = hi_bf(w0.z); v[6] = lo_bf(w0.w); v[7] = hi_bf(w0.w);
    v[8] = lo_bf(w1.x); v[9] = hi_bf(w1.x); v[10] = lo_bf(w1.y); v[11] = hi_bf(w1.y); v[12] = lo_bf(w1.z); v[13] = hi_bf(w1.z); v[14] = lo_bf(w1.w); v[15] = hi_bf(w1.w);
}
__device__ __forceinline__ void ans_store(bf16* tile, const f32x16& v, int lane) { v4u w0, w1; ans_pack(v, w0, w1); *(v4u*)(tile + lane * 8) = w0; *(v4u*)(tile + 512 + lane * 8) = w1; }
__device__ __forceinline__ bf16* yslot(bf16* Y, int tok0, int h, int eo) { return Y + (size_t)(tok0 + (eo >> 7)) * D + 512 + 128 * h + (eo & 127); }

#define XB_TMO      128
#define XB_XCNT(j)  (256  + 64 * (j))
#define XB_XSUB(j)  (1280 + 64 * (j))
#define XB_XGEN(j)  (2304 + 64 * (j))
#define XB_TOP      3328
#define XB_TOPGEN   3392
#define XCD_BAR_WORDS 3456
#define XB_SPIN_CAP (1u << 18)

__device__ __forceinline__ unsigned xb_ld(unsigned* p)              { return __hip_atomic_load(p, __ATOMIC_RELAXED, __HIP_MEMORY_SCOPE_AGENT); }
__device__ __forceinline__ unsigned xb_add(unsigned* p, unsigned v) { return __hip_atomic_fetch_add(p, v, __ATOMIC_RELAXED, __HIP_MEMORY_SCOPE_AGENT); }
__device__ __forceinline__ unsigned xb_xcc_id() { return (unsigned)__builtin_amdgcn_s_getreg((3 << 11) | 20) & 0xFu; }
#define XB_SPIN(cond, bar) do { unsigned _sp = 0; while (cond) { __builtin_amdgcn_s_sleep(1); \
    if ((++_sp & 255u) == 0u) { if (xb_ld(&(bar)[XB_TMO])) break; if (_sp > XB_SPIN_CAP) { atomicAdd(&(bar)[XB_TMO], 1u); break; } } } } while (0)

struct XcdBarrier {
    unsigned* bar; unsigned x;
    volatile LAS unsigned* st;
};

__device__ __forceinline__ XcdBarrier xcd_barrier_post(unsigned* bar, volatile LAS unsigned* st) {
    XcdBarrier b; b.bar = bar; b.x = xb_xcc_id(); b.st = st;
    if (threadIdx.x == 0) (void)xb_add(&bar[XB_XCNT(b.x)], 1u);
    return b;
}
__device__ __forceinline__ void xcd_barrier_complete(unsigned* bar, unsigned x, unsigned& nloc, unsigned& nx) {
    const unsigned G = gridDim.x * gridDim.y * gridDim.z;
    unsigned sum, cnt, mine, sp = 0u;
    for (;;) {
        sum = 0u; cnt = 0u; mine = 0u;
#pragma unroll
        for (unsigned j = 0; j < 16; ++j) { const unsigned c = xb_ld(&bar[XB_XCNT(j)]); sum += c; cnt += (c > 0u) ? 1u : 0u; mine = (j == x) ? c : mine; }
        if (sum == G) break;
        __builtin_amdgcn_s_sleep(1);
        if ((++sp & 255u) == 0u) { if (xb_ld(&bar[XB_TMO])) break; if (sp > XB_SPIN_CAP) { atomicAdd(&bar[XB_TMO], 1u); break; } }
    }
    nloc = mine > 0u ? mine : 1u; nx = cnt > 0u ? cnt : 1u;
}

__device__ __forceinline__ void xcd_barrier(const XcdBarrier& b) {
    asm volatile("s_waitcnt vmcnt(0)" ::: "memory");
    __syncthreads();
    if (threadIdx.x == 0) {
        unsigned* bar = b.bar;
        __builtin_amdgcn_s_waitcnt(0);
        unsigned nloc = b.st[0], nx = b.st[1];
        if (nloc == 0u) { xcd_barrier_complete(bar, b.x, nloc, nx); b.st[0] = nloc; b.st[1] = nx; }
        const unsigned old = xb_add(&bar[XB_XSUB(b.x)], 1u);
        const unsigned gen = old / nloc;
        if (old + 1u == (gen + 1u) * nloc) {
            __builtin_amdgcn_fence(__ATOMIC_RELEASE, "agent");
            asm volatile("s_waitcnt vmcnt(0)" ::: "memory");
            const unsigned og = xb_add(&bar[XB_TOP], 1u);
            const unsigned tg = og / nx;
            if (og + 1u == (tg + 1u) * nx) xb_add(&bar[XB_TOPGEN], 1u);
            else XB_SPIN(xb_ld(&bar[XB_TOPGEN]) == tg, bar);
            __builtin_amdgcn_fence(__ATOMIC_ACQUIRE, "agent");
            xb_add(&bar[XB_XGEN(b.x)], 1u);
            asm volatile("s_waitcnt vmcnt(0)" ::: "memory");
        } else {
            XB_SPIN(xb_ld(&bar[XB_XGEN(b.x)]) == gen, bar);
            __builtin_amdgcn_fence(__ATOMIC_ACQUIRE, "agent");
            asm volatile("s_waitcnt vmcnt(0)" ::: "memory");
        }
    }
    __syncthreads();
}


using pg8::Unit;
struct EpiSwiglu {
    static constexpr bool PERM = true, AFTER_DRAIN = false;
    bf16* Hd; const float* ss;
    __device__ __forceinline__ void operator()(const f32x4 (&acc)[2][2][4][2], const Unit& u, int wr, int wc, int fr, int fq) const {
        const int row0 = u.pm * 256 + wr * 64 + fr, col0 = u.pn * 128 + wc * 32 + 8 * fq;
#pragma unroll
        for (int ai = 0; ai < 2; ++ai)
#pragma unroll
            for (int m = 0; m < 4; ++m) {
                const int row = row0 + ai * 128 + m * 16; const float rs = rsqrtf(ss[row] * (1.0f / D) + EPS);
                float hv[8];
#pragma unroll
                for (int n = 0; n < 2; ++n)
#pragma unroll
                    for (int q = 0; q < 4; q += 2) { const float g0 = acc[ai][0][m][n][q] * rs, g1 = acc[ai][0][m][n][q + 1] * rs, u0 = acc[ai][1][m][n][q] * rs, u1 = acc[ai][1][m][n][q + 1] * rs;
                        float s0, s1; sigm2(g0, g1, s0, s1); hv[4 * n + q] = g0 * s0 * u0; hv[4 * n + q + 1] = g1 * s1 * u1; }
                v4u w; w.x = pk2(hv[0], hv[1]); w.y = pk2(hv[2], hv[3]); w.z = pk2(hv[4], hv[5]); w.w = pk2(hv[6], hv[7]);
                *(v4u*)(Hd + (size_t)row * FF + col0) = w;
            }
    }
};
struct EpiResid {
    static constexpr bool PERM = false, AFTER_DRAIN = false;
    const float* base; float* out; bf16* xb; float* ss; float alpha;
    __device__ __forceinline__ void operator()(const f32x4 (&acc)[2][2][4][2], const Unit& u, int wr, int wc, int fr, int fq) const {
        const int row0 = u.pm * 256 + wr * 64 + fr, col0 = u.pn * 256 + wc * 32 + 4 * fq;
#pragma unroll
        for (int ai = 0; ai < 2; ++ai) {
            f32x4 bv[4][2][2];
#pragma unroll
            for (int m = 0; m < 4; ++m)
#pragma unroll
                for (int bj = 0; bj < 2; ++bj)
#pragma unroll
                    for (int n = 0; n < 2; ++n) bv[m][bj][n] = *(const f32x4*)(base + (size_t)(row0 + ai * 128 + m * 16) * D + col0 + bj * 128 + n * 16);
            asm volatile("" ::: "memory");
#pragma unroll
            for (int m = 0; m < 4; ++m) {
                const int row = row0 + ai * 128 + m * 16; float s = 0.f;
#pragma unroll
                for (int bj = 0; bj < 2; ++bj)
#pragma unroll
                    for (int n = 0; n < 2; ++n) {
                        const size_t off = (size_t)row * D + col0 + bj * 128 + n * 16;
                        const f32x4 v = bv[m][bj][n] + acc[ai][bj][m][n] * alpha;
                        *(f32x4*)(out + off) = v; s += (v[0] * v[0] + v[1] * v[1]) + (v[2] * v[2] + v[3] * v[3]);
                        if (xb) { v2u w; w.x = pk2(v[0], v[1]); w.y = pk2(v[2], v[3]); *(v2u*)(xb + off) = w; }
                    }
                s += __shfl_xor(s, 16); s += __shfl_xor(s, 32);
                if (fq == 0) atomicAdd(ss + row, s);
            }
        }
    }
};
struct EpiFinal {
    static constexpr bool PERM = false, AFTER_DRAIN = false;
    const float* base; float* out; float* ss; unsigned* cnt; const float* fn; float alpha;
    __device__ __forceinline__ void operator()(const f32x4 (&acc_)[2][2][4][2], const Unit& u, int wr, int wc, int fr, int fq) const {
        f32x4 (&acc)[2][2][4][2] = const_cast<f32x4 (&)[2][2][4][2]>(acc_);
        const int row0 = u.pm * 256 + wr * 64 + fr, col0 = u.pn * 256 + wc * 32 + 4 * fq;
#pragma unroll
        for (int ai = 0; ai < 2; ++ai) {
            f32x4 bv[4][2][2];
#pragma unroll
            for (int m = 0; m < 4; ++m)
#pragma unroll
                for (int bj = 0; bj < 2; ++bj)
#pragma unroll
                    for (int n = 0; n < 2; ++n) bv[m][bj][n] = *(const f32x4*)(base + (size_t)(row0 + ai * 128 + m * 16) * D + col0 + bj * 128 + n * 16);
#pragma unroll
            for (int m = 0; m < 4; ++m) { float s = 0.f;
#pragma unroll
                for (int bj = 0; bj < 2; ++bj)
#pragma unroll
                    for (int n = 0; n < 2; ++n) { const f32x4 v = bv[m][bj][n] + acc[ai][bj][m][n] * alpha; acc[ai][bj][m][n] = v; s += (v[0] * v[0] + v[1] * v[1]) + (v[2] * v[2] + v[3] * v[3]); }
                s += __shfl_xor(s, 16); s += __shfl_xor(s, 32);
                if (fq == 0) atomicAdd(ss + row0 + ai * 128 + m * 16, s);
            }
        }
        asm volatile("s_waitcnt vmcnt(0)" ::: "memory");
        __builtin_amdgcn_s_barrier(); asm volatile("" ::: "memory");
        if (threadIdx.x == 0) {
            unsigned* c = cnt + 64 * u.pm;
            __hip_atomic_fetch_add(c, 1u, __ATOMIC_RELAXED, __HIP_MEMORY_SCOPE_AGENT);
            unsigned spins = 0;
            while (__hip_atomic_load(c, __ATOMIC_RELAXED, __HIP_MEMORY_SCOPE_AGENT) < 4u && ++spins < (1u << 22)) __builtin_amdgcn_s_sleep(2);
        }
        __builtin_amdgcn_s_barrier(); asm volatile("" ::: "memory");
        f32x4 gv[2][2];
#pragma unroll
        for (int bj = 0; bj < 2; ++bj)
#pragma unroll
            for (int n = 0; n < 2; ++n) gv[bj][n] = *(const f32x4*)(fn + col0 + bj * 128 + n * 16);
#pragma unroll
        for (int ai = 0; ai < 2; ++ai)
#pragma unroll
            for (int m = 0; m < 4; ++m) { const int row = row0 + ai * 128 + m * 16;
                const float rs = rsqrtf(__hip_atomic_load(ss + row, __ATOMIC_RELAXED, __HIP_MEMORY_SCOPE_AGENT) * (1.0f / D) + EPS);
#pragma unroll
                for (int bj = 0; bj < 2; ++bj)
#pragma unroll
                    for (int n = 0; n < 2; ++n) *(f32x4*)(out + (size_t)row * D + col0 + bj * 128 + n * 16) = acc[ai][bj][m][n] * rs * gv[bj][n]; }
    }
};
struct EpiProj {
    static constexpr bool PERM = true, AFTER_DRAIN = false;
    bf16* P; const float* ss;
    __device__ __forceinline__ void operator()(const f32x4 (&acc)[2][2][4][2], const Unit& u, int wr, int wc, int fr, int fq) const {
        const int row0 = u.pm * 256 + wr * 64 + fr, col0 = u.pn * 256 + wc * 32 + 8 * fq; const int act = u.pn < 4 ? 1 : (u.pn < 10 ? 0 : 2);
#pragma unroll
        for (int ai = 0; ai < 2; ++ai)
#pragma unroll
            for (int m = 0; m < 4; ++m) {
                const int row = row0 + ai * 128 + m * 16; const float rs = rsqrtf(ss[row] * (1.0f / D) + EPS);
#pragma unroll
                for (int bj = 0; bj < 2; ++bj) {
                    float hv[8];
#pragma unroll
                    for (int n = 0; n < 2; ++n)
#pragma unroll
                        for (int q = 0; q < 4; q += 2) { float v0 = acc[ai][bj][m][n][q] * rs, v1 = acc[ai][bj][m][n][q + 1] * rs;
                            if (act != 0) { float z0 = v0, z1 = v1; if (act == 1) { z0 = 1.5957691216057308f * (v0 + 0.044715f * v0 * v0 * v0); z1 = 1.5957691216057308f * (v1 + 0.044715f * v1 * v1 * v1); }
                                float s0, s1; sigm2(z0, z1, s0, s1); v0 *= s0; v1 *= s1; }
                            hv[4 * n + q] = v0; hv[4 * n + q + 1] = v1; }
                    v4u w; w.x = pk2(hv[0], hv[1]); w.y = pk2(hv[2], hv[3]); w.z = pk2(hv[4], hv[5]); w.w = pk2(hv[6], hv[7]);
                    *(v4u*)(P + (size_t)row * NIN + col0 + bj * 128) = w;
                }
            }
    }
};

struct Args { const float* in[21]; float* out; unsigned char* ws; int ph_lo, ph_hi; };

__device__ __forceinline__ void transpose_item(const float* W, int ldn, int K, const float* gain, bf16* WT, int k0, int n0, int dst_row0, LAS float* scr, int lane) {
    float tv[32];
#pragma unroll
    for (int i = 0; i < 32; ++i) tv[i] = __builtin_nontemporal_load(W + (size_t)(k0 + 2 * i + (lane >> 5)) * ldn + n0 + (lane & 31));
#pragma unroll
    for (int i = 0; i < 32; ++i) { const int kk = 2 * i + (lane >> 5); float v = tv[i]; if (gain) v *= gain[k0 + kk]; scr[kk * 33 + (lane & 31)] = v; }
    LDS_WAIT(); asm volatile("" ::: "memory");
    const int c = lane & 7;
#pragma unroll
    for (int j = 0; j < 4; ++j) { const int n = (lane >> 3) + 8 * j; const LAS float* s = scr + (8 * c) * 33 + n;
        v4u o; o.x = pk2(s[0 * 33], s[1 * 33]); o.y = pk2(s[2 * 33], s[3 * 33]); o.z = pk2(s[4 * 33], s[5 * 33]); o.w = pk2(s[6 * 33], s[7 * 33]);
        *(v4u*)(WT + (size_t)(dst_row0 + n) * K + k0 + 8 * c) = o; }
    LDS_WAIT(); asm volatile("" ::: "memory");
}
__device__ __forceinline__ void p0_prologue(const Args& a, LAS unsigned char* lds, int wave, int lane, int grp, int gw, int NGW) {
    unsigned char* ws = a.ws;
    LAS float* scr = (LAS float*)(lds + wave * 16384);
    constexpr int I_GU = (D / 64) * (FF / 32), I_DN = (FF / 64) * (D / 32), I_IN = (D / 64) * (NIN / 32), I_OUT = (D / 64) * (D / 32);
    constexpr int NITEMS = 4 * I_GU + 2 * I_DN + I_IN + I_OUT;
    for (int it = gw; it < NITEMS; it += NGW) {
        int r = it;
        if (r < 4 * I_GU) {
            const int which = r / I_GU; r -= which * I_GU; if ((which >= 2 ? 2 : 0) != grp) continue; const int nblk = FF / 32, kb = r / nblk, nb = r % nblk, n0 = 32 * nb;
            const float* W = a.in[which == 0 ? 2 : which == 1 ? 3 : which == 2 ? 17 : 18]; const float* gn = a.in[which < 2 ? 1 : 16];
            bf16* WT = (bf16*)(ws + (which < 2 ? WS_WGU1 : WS_WGU2));
            const int dst = 256 * (n0 / 128) + (n0 % 128) + ((which & 1) ? 128 : 0);
            transpose_item(W, FF, D, gn, WT, 64 * kb, n0, dst, scr, lane); continue; }
        r -= 4 * I_GU;
        if (r < 2 * I_DN) { const int which = r / I_DN; r -= which * I_DN; if ((which == 1 ? 2 : 1) != grp) continue; const int nblk = D / 32, kb = r / nblk, nb = r % nblk;
            transpose_item(a.in[which ? 19 : 4], D, FF, nullptr, (bf16*)(ws + (which ? WS_WD2 : WS_WD1)), 64 * kb, 32 * nb, 32 * nb, scr, lane); continue; }
        r -= 2 * I_DN;
        if (r < I_IN) { if (grp != 1) continue; const int nblk = NIN / 32, kb = r / nblk, nb = r % nblk;
            transpose_item(a.in[6], DIN, D, a.in[5], (bf16*)(ws + WS_WIN), 64 * kb, 32 * nb, 32 * nb, scr, lane); continue; }
        r -= I_IN;
        if (grp == 2) { const int nblk = D / 32, kb = r / nblk, nb = r % nblk;
            transpose_item(a.in[15], D, D, nullptr, (bf16*)(ws + WS_WOUT), 64 * kb, 32 * nb, 32 * nb, scr, lane); }
    }
    if (grp != 0) return;
    { float* wex = (float*)(ws + WS_WEX); const int gt = blockIdx.x * NTHR + threadIdx.x;
      if (gt < 8 * D) { const int j = gt / D, k = gt % D; wex[gt] = a.in[6][(size_t)k * DIN + NIN + j] * a.in[5][k]; } }
    { const float* x = a.in[0]; bf16* xb = (bf16*)(ws + WS_XB); float* ss1 = (float*)(ws + WS_CTL);
      for (int m0 = gw * 8; m0 < M; m0 += NGW * 8) {
          f32x4 v[8][4];
#pragma unroll
          for (int r8 = 0; r8 < 8; ++r8) { const f32x4* xr = (const f32x4*)(x + (size_t)(m0 + r8) * D) + lane;
#pragma unroll
              for (int j = 0; j < 4; ++j) v[r8][j] = __builtin_nontemporal_load(xr + 64 * j); }
#pragma unroll
          for (int r8 = 0; r8 < 8; ++r8) { float sq = 0.f;
#pragma unroll
              for (int j = 0; j < 4; ++j) sq += (v[r8][j][0] * v[r8][j][0] + v[r8][j][1] * v[r8][j][1]) + (v[r8][j][2] * v[r8][j][2] + v[r8][j][3] * v[r8][j][3]);
              sq = wave_sum(sq);
              v2u* o8 = (v2u*)(xb + (size_t)(m0 + r8) * D) + lane;
#pragma unroll
              for (int j = 0; j < 4; ++j) { v2u w; w.x = pk2(v[r8][j][0], v[r8][j][1]); w.y = pk2(v[r8][j][2], v[r8][j][3]); o8[64 * j] = w; }
              if (lane == 0) ss1[m0 + r8] = sq; }
      } }
}

__device__ __forceinline__ void pex_rows(unsigned char* ws, int wave, int lane) {
    const bf16* xb = (const bf16*)(ws + WS_XB); const float* wex = (const float*)(ws + WS_WEX); const float* ss2 = (const float*)(ws + WS_CTL) + M; float* pex = (float*)(ws + WS_PEX);
    const int gw = blockIdx.x * NWAVES + wave, NGW = gridDim.x * NWAVES;
    unsigned wq[8][8];
#pragma unroll
    for (int j = 0; j < 8; ++j)
#pragma unroll
        for (int q = 0; q < 4; ++q) { const f32x4 w = *(const f32x4*)(wex + j * D + 16 * lane + 4 * q); wq[j][2 * q] = pk2(w[0], w[1]); wq[j][2 * q + 1] = pk2(w[2], w[3]); }
    for (int m = gw; m < M; m += NGW) {
        const v4u* xr = (const v4u*)(xb + (size_t)m * D + 16 * lane); const v4u a0 = xr[0], a1 = xr[1];
        const unsigned xw[8] = { a0.x, a0.y, a0.z, a0.w, a1.x, a1.y, a1.z, a1.w };
        float sj[8];
#pragma unroll
        for (int j = 0; j < 8; ++j) { float s = 0.f;
#pragma unroll
            for (int q = 0; q < 8; ++q) s += lo_bf(xw[q]) * lo_bf(wq[j][q]) + hi_bf(xw[q]) * hi_bf(wq[j][q]);
            sj[j] = s; }
        float t4[4], t2[2], t1;
#pragma unroll
        for (int q = 0; q < 4; ++q) { const bool up = lane & 1; const float keep = up ? sj[2 * q + 1] : sj[2 * q], give = up ? sj[2 * q] : sj[2 * q + 1]; t4[q] = keep + __shfl_xor(give, 1); }
#pragma unroll
        for (int q = 0; q < 2; ++q) { const bool up = lane & 2; const float keep = up ? t4[2 * q + 1] : t4[2 * q], give = up ? t4[2 * q] : t4[2 * q + 1]; t2[q] = keep + __shfl_xor(give, 2); }
        { const bool up = lane & 4; const float keep = up ? t2[1] : t2[0], give = up ? t2[0] : t2[1]; t1 = keep + __shfl_xor(give, 4); }
        t1 += __shfl_xor(t1, 8); t1 += __shfl_xor(t1, 16); t1 += __shfl_xor(t1, 32);
        if (lane < 8) pex[(size_t)m * 8 + lane] = t1 * rsqrtf(ss2[m] * (1.0f / D) + EPS);
    }
}

__device__ __forceinline__ void gmlp_item(const Args& a, LAS unsigned char* lds, int it2, int tid, int wave, int lane) {
    const int it = it2 >> 1, half = it2 & 1;
    unsigned char* ws = a.ws; const bf16* P = (const bf16*)(ws + WS_H); bf16* Y = (bf16*)(ws + WS_Y);
    const float* lng = a.in[7]; const float* lnb = a.in[8]; const float* Ws = a.in[9]; const float* bs = a.in[10];
    const int r0 = it * 128;
    constexpr int VS = 272;
    LAS unsigned char* vnT = lds;
    LAS float* stat = (LAS float*)(lds + 256 * VS);
    { v4u vv[16];
#pragma unroll
      for (int t = 0; t < 16; ++t) vv[t] = *(const v4u*)(P + (size_t)(r0 + wave * 16 + t) * NIN + 512 + 8 * lane);
#pragma unroll
      for (int t = 0; t < 16; ++t) { const v4u v = vv[t];
        const float f[8] = { lo_bf(v.x), hi_bf(v.x), lo_bf(v.y), hi_bf(v.y), lo_bf(v.z), hi_bf(v.z), lo_bf(v.w), hi_bf(v.w) };
        float s1 = 0.f, s2 = 0.f;
#pragma unroll
        for (int q = 0; q < 8; ++q) { s1 += f[q]; s2 += f[q] * f[q]; }
        s1 = wave_sum(s1); s2 = wave_sum(s2);
        const float mean = s1 * (1.0f / 512.0f), var = fmaxf(s2 * (1.0f / 512.0f) - mean * mean, 0.f);
        if (lane == 0) { stat[2 * (wave * 16 + t)] = mean; stat[2 * (wave * 16 + t) + 1] = rsqrtf(var + EPS); } } }
    WG_BAR();
    {
#pragma unroll 2
        for (int r = 0; r < 8; ++r) { const int task = tid + NTHR * r, j = task & 127, cgp = task >> 7, c0 = 256 * half + 8 * cgp;
            const v4u v = *(const v4u*)(P + (size_t)(r0 + j) * NIN + 512 + c0);
            const float f[8] = { lo_bf(v.x), hi_bf(v.x), lo_bf(v.y), hi_bf(v.y), lo_bf(v.z), hi_bf(v.z), lo_bf(v.w), hi_bf(v.w) };
            const float mean = stat[2 * j], rs = stat[2 * j + 1];
#pragma unroll
            for (int q = 0; q < 8; ++q) { const float o = (f[q] - mean) * rs * lng[c0 + q] + lnb[c0 + q];
                *(LAS unsigned short*)(vnT + (8 * cgp + q) * VS + 2 * j) = (unsigned short)(pk2(o, 0.f) & 0xffffu); }
        }
        WG_BAR();
        const int ti = wave >> 1, tc = wave & 1, rr = lane & 31, hh = lane >> 5;
        for (int gl = 0; gl < 4; ++gl) { const int g = 4 * half + gl;
            f32x16 acc = zero16();
            const float* Wg = Ws + (size_t)g * 128 * 128 + (size_t)(32 * ti + rr) * 128 + 8 * hh;
            const LAS unsigned char* bp = vnT + (64 * gl + 32 * tc + rr) * VS + 16 * hh;
            const int nks = ti < 2 ? 4 : 8;
            bf16x8 av[8];
#pragma unroll
            for (int ks = 0; ks < 8; ++ks) if (ks < nks) {
                const f32x4 w0 = *(const f32x4*)(Wg + 16 * ks), w1 = *(const f32x4*)(Wg + 16 * ks + 4);
                v4u aw; aw.x = pk2(w0[0], w0[1]); aw.y = pk2(w0[2], w0[3]); aw.z = pk2(w1[0], w1[1]); aw.w = pk2(w1[2], w1[3]);
                av[ks] = __builtin_bit_cast(bf16x8, aw); }
#pragma unroll
            for (int ks = 0; ks < 8; ++ks) if (ks < nks) {
                const bf16x8 bv = *(const LAS bf16x8*)(bp + 32 * ks);
                acc = __builtin_amdgcn_mfma_f32_32x32x16_bf16(bv, av[ks], acc, 0, 0, 0);
            }
            const int i = 32 * ti + rr; const float bias = bs[g * 128 + i];
            const bf16* up = P + (size_t)(r0 + i) * NIN + 64 * g + 32 * tc + 4 * hh; bf16* yp = Y + (size_t)(r0 + i) * D + 64 * g + 32 * tc + 4 * hh;
            v2u uv[4];
#pragma unroll
            for (int g4 = 0; g4 < 4; ++g4) uv[g4] = *(const v2u*)(up + 8 * g4);
#pragma unroll
            for (int g4 = 0; g4 < 4; ++g4) { v2u w; w.x = pk2(lo_bf(uv[g4].x) * (acc[4 * g4] + bias), hi_bf(uv[g4].x) * (acc[4 * g4 + 1] + bias)); w.y = pk2(lo_bf(uv[g4].y) * (acc[4 * g4 + 2] + bias), hi_bf(uv[g4].y) * (acc[4 * g4 + 3] + bias));
                *(v2u*)(yp + 8 * g4) = w; }
        }
        WG_BAR();
    }
}


template <int J> __device__ __forceinline__ void fmac_rowbcast(float& acc, int l, float xv) { asm("v_fmac_f32_dpp %0, %1, %2 row_newbcast:%3 row_mask:0xf bank_mask:0xf" : "+v"(acc) : "v"(l), "v"(xv), "n"(J)); }
__device__ __forceinline__ void fmac_rowbcast_sel(float& acc, int l, float xv, int j) {
    switch (j & 15) { case 0: fmac_rowbcast<0>(acc, l, xv); break; case 1: fmac_rowbcast<1>(acc, l, xv); break; case 2: fmac_rowbcast<2>(acc, l, xv); break; case 3: fmac_rowbcast<3>(acc, l, xv); break;
        case 4: fmac_rowbcast<4>(acc, l, xv); break; case 5: fmac_rowbcast<5>(acc, l, xv); break; case 6: fmac_rowbcast<6>(acc, l, xv); break; case 7: fmac_rowbcast<7>(acc, l, xv); break;
        case 8: fmac_rowbcast<8>(acc, l, xv); break; case 9: fmac_rowbcast<9>(acc, l, xv); break; case 10: fmac_rowbcast<10>(acc, l, xv); break; case 11: fmac_rowbcast<11>(acc, l, xv); break;
        case 12: fmac_rowbcast<12>(acc, l, xv); break; case 13: fmac_rowbcast<13>(acc, l, xv); break; case 14: fmac_rowbcast<14>(acc, l, xv); break; default: fmac_rowbcast<15>(acc, l, xv); break; }
}

constexpr int KS_ = 272, AS_ = 144;
constexpr int L_KH = 0, L_QS = L_KH + 64 * KS_, L_LM = L_QS + 64 * KS_, L_AT = L_LM + 64 * 272, L_SOL = L_AT + 64 * AS_, L_KDT = L_SOL + 256 * AS_, L_V = L_KDT + 128 * AS_, L_GC = L_V + 64 * KS_, L_BETA = L_GC + 256, L_BK = L_BETA + 256, L_CW = L_BK + 256, L_END = L_CW + 3 * 4 * 128 * 4;
static_assert(L_END <= LDS_BYTES, "prep LDS");
__device__ __forceinline__ void dn_prep_item(const Args& a, LAS unsigned char* lds, int item, int tid, int wave, int lane, int& cwh, int next_item) {
    unsigned char* ws = a.ws; const bf16* P = (const bf16*)(ws + WS_H); bf16* Y = (bf16*)(ws + WS_Y);
    const float* cw = a.in[11]; const float* pex = (const float*)(ws + WS_PEX);
    const int h = item & 3, n = (item >> 2) & (NCH - 1), b = item >> 9; const int tok0 = b * T + n * 64;
    LAS float* cwl = (LAS float*)(lds + L_CW);
    if (h != cwh) { cwh = h;
        for (int idx = tid; idx < 1536; idx += NTHR) { const int which = idx >> 9, jj = (idx >> 7) & 3, c = idx & 127; cwl[idx] = cw[jj * 1536 + which * 512 + h * 128 + c]; } }
    LAS float* gcs = (LAS float*)(lds + L_GC); LAS float* betas = (LAS float*)(lds + L_BETA); LAS float* bks = (LAS float*)(lds + L_BK); LAS float* Lm = (LAS float*)(lds + L_LM);
    if (wave == 0) {
        const float araw = pex[(size_t)(tok0 + lane) * 8 + 4 + h], braw = pex[(size_t)(tok0 + lane) * 8 + h];
        const float xx = araw + a.in[13][h]; const float sp = fmaxf(xx, 0.f) + __logf(1.f + __expf(-fabsf(xx)));
        float g = -__expf(a.in[12][h]) * sp;
#pragma unroll
        for (int o = 1; o < 64; o <<= 1) { const float t = __shfl_up(g, o); if (lane >= o) g += t; }
        const float be = sigm(braw); gcs[lane] = g; betas[lane] = be; bks[lane] = be * __expf(g);
    }
    WG_BAR();
#pragma unroll 3
    for (int r = 0; r < 6; ++r) { const int task = tid + NTHR * r, which = task >> 10, i = (task & 1023) >> 4, gq = task & 15;
        const int col = 1024 + which * 512 + h * 128 + 8 * gq;
        v4u xv[4];
#pragma unroll
        for (int jj = 0; jj < 4; ++jj) { const int pos = n * 64 + i - 3 + jj; xv[jj] = (v4u){0u, 0u, 0u, 0u};
            if (pos >= 0) xv[jj] = *(const v4u*)(P + (size_t)(b * T + pos) * NIN + col); }
        float o[8];
#pragma unroll
        for (int q = 0; q < 8; ++q) o[q] = 0.f;
#pragma unroll
        for (int jj = 0; jj < 4; ++jj) { const v4u v = xv[jj];
            const f32x4 w0 = *(const LAS f32x4*)(cwl + (which * 4 + jj) * 128 + 8 * gq), w1 = *(const LAS f32x4*)(cwl + (which * 4 + jj) * 128 + 8 * gq + 4);
            o[0] += w0[0] * lo_bf(v.x); o[1] += w0[1] * hi_bf(v.x); o[2] += w0[2] * lo_bf(v.y); o[3] += w0[3] * hi_bf(v.y);
            o[4] += w1[0] * lo_bf(v.z); o[5] += w1[1] * hi_bf(v.z); o[6] += w1[2] * lo_bf(v.w); o[7] += w1[3] * hi_bf(v.w); }
        float s = 0.f;
#pragma unroll
        for (int q = 0; q < 8; ++q) { o[q] = silu_(o[q]); s += o[q] * o[q]; }
        s += __shfl_xor(s, 1); s += __shfl_xor(s, 2); s += __shfl_xor(s, 4); s += __shfl_xor(s, 8);
        const float inv = which == 2 ? 1.0f : rsqrtf(s + EPS) * (which == 0 ? 0.08838834764831845f : 1.0f);
        v4u w; w.x = pk2(o[0] * inv, o[1] * inv); w.y = pk2(o[2] * inv, o[3] * inv); w.z = pk2(o[4] * inv, o[5] * inv); w.w = pk2(o[6] * inv, o[7] * inv);
        *(LAS v4u*)(lds + (which == 0 ? L_QS : which == 1 ? L_KH : L_V) + i * KS_ + 16 * gq) = w;
    }
    WG_BAR();
    { const int ti = wave & 1, tj = (wave >> 1) & 1, isq = wave >> 2, rr = lane & 31, hh = lane >> 5;
      f32x16 acc = zero16();
      if (!(ti == 0 && tj == 1)) mm_lds<8>(acc, lds + (isq ? L_QS : L_KH) + 32 * ti * KS_, KS_, lds + L_KH + 32 * tj * KS_, KS_, lane);
      const int j = 32 * tj + rr; const float gj = gcs[j];
#pragma unroll
      for (int r = 0; r < 16; ++r) { const int i = 32 * ti + (r & 3) + 8 * (r >> 2) + 4 * hh;
          const float dec = __expf(fminf(gcs[i] - gj, 0.f));
          if (isq) { const float v = (i >= j) ? acc[r] * dec : 0.f; *(LAS unsigned short*)(lds + L_AT + i * AS_ + 2 * j) = (unsigned short)(pk2(v, 0.f) & 0xffffu); }
          else { Lm[i * 68 + j] = (i > j) ? -(betas[i] * acc[r] * dec) : 0.f; } }
    }
    WG_BAR();
    if (wave < 4) {
        float x[64];
        { const LAS unsigned char* src = lds + (tid < 128 ? L_V : L_KH) + 2 * (tid & 127); const LAS float* fac = tid < 128 ? betas : bks;
#pragma unroll
          for (int i = 0; i < 64; ++i) x[i] = bf2f(*(const LAS unsigned short*)(src + i * KS_)) * fac[i]; }
        { const LAS float* lrow = Lm + (lane & 15);
#pragma unroll
        for (int i = 1; i < 64; ++i) { float sa[4] = { x[i], 0.f, 0.f, 0.f };
            int lr[4];
#pragma unroll
            for (int g = 0; g < (i + 15) / 16; ++g) lr[g] = __float_as_int(lrow[i * 68 + 16 * g]);
#pragma unroll
            for (int j = 0; j < i; ++j) { fmac_rowbcast_sel(sa[j & 3], lr[j >> 4], x[j], j); }
            x[i] = (sa[0] + sa[1]) + (sa[2] + sa[3]); } }
#pragma unroll
        for (int q = 0; q < 8; ++q) { v4u w; w.x = pk2(x[8 * q], x[8 * q + 1]); w.y = pk2(x[8 * q + 2], x[8 * q + 3]); w.z = pk2(x[8 * q + 4], x[8 * q + 5]); w.w = pk2(x[8 * q + 6], x[8 * q + 7]);
            *(LAS v4u*)(lds + L_SOL + tid * AS_ + 16 * q) = w; }
    } else {
        const int t2 = tid - 256; const float gl = gcs[63];
#pragma unroll 4
        for (int r = 0; r < 32; ++r) { const int idx = t2 + 256 * r, i = idx & 63, d = idx >> 6;
            const float v = bf2f(*(const LAS unsigned short*)(lds + L_KH + i * KS_ + 2 * d)) * __expf(gl - gcs[i]);
            *(LAS unsigned short*)(lds + L_KDT + d * AS_ + 2 * i) = (unsigned short)(pk2(v, 0.f) & 0xffffu); }
        if (next_item >= 0) { const int h2 = next_item & 3, n2 = (next_item >> 2) & (NCH - 1), b2 = next_item >> 9; unsigned d0 = 0u, d1 = 0u;
            const unsigned char* pb = (const unsigned char*)(P + (size_t)(b2 * T + n2 * 64) * NIN + 1024 + h2 * 128);
            { const int idx = t2, row = idx / 6, seg = idx % 6; if (n2 > 0 || row >= 3) asm volatile("global_load_dword %0, %1, off" : "+v"(d0) : "v"(pb + (ptrdiff_t)(row - 3) * (NIN * 2) + (seg >> 1) * 1024 + (seg & 1) * 128) : "memory"); }
            { const int idx = t2 + 256, row = idx / 6, seg = idx % 6; if (idx < 402) asm volatile("global_load_dword %0, %1, off" : "+v"(d1) : "v"(pb + (ptrdiff_t)(row - 3) * (NIN * 2) + (seg >> 1) * 1024 + (seg & 1) * 128) : "memory"); }
            asm volatile("s_waitcnt vmcnt(0)" ::: "memory"); asm volatile("" :: "v"(d0), "v"(d1)); }
    }
    WG_BAR();
    { const int rr = lane & 31, hh = lane >> 5;
      bf16* Ms = (bf16*)(ws + WS_MS) + (size_t)item * 16384; bf16* Bs = (bf16*)(ws + WS_BS) + (size_t)item * 16384; bf16* Qp = (bf16*)(ws + WS_QP) + (size_t)item * 8192;
#pragma unroll 1
      for (int tt = 0; tt < 2; ++tt) { const int tile = 2 * wave + tt, tdp = tile >> 2, td = tile & 3;
          f32x16 acc = zero16(); mm_lds<4>(acc, lds + L_SOL + (128 + 32 * tdp) * AS_, AS_, lds + L_KDT + 32 * td * AS_, AS_, lane);
#pragma unroll
          for (int r = 0; r < 16; ++r) acc[r] = -acc[r];
          ans_store(Ms + (td * 4 + tdp) * 1024, acc, lane); }
#pragma unroll 1
      for (int tt = 0; tt < 2; ++tt) { const int tile = 2 * wave + tt, td = tile >> 2, te = tile & 3;
          f32x16 acc = zero16(); mm_lds<4>(acc, lds + L_KDT + 32 * td * AS_, AS_, lds + L_SOL + 32 * te * AS_, AS_, lane);
          ans_store(Bs + (te * 4 + td) * 1024, acc, lane); }
      { const int td = wave >> 1, ti = wave & 1;
          f32x16 acc = zero16(); mm_lds<4>(acc, lds + L_SOL + (128 + 32 * td) * AS_, AS_, lds + L_AT + 32 * ti * AS_, AS_, lane);
          const int i = 32 * ti + rr; const float eg = __expf(gcs[i]);
#pragma unroll
          for (int g = 0; g < 4; ++g) { const v2u qv = *(const LAS v2u*)(lds + L_QS + i * KS_ + 2 * (32 * td + 8 * g + 4 * hh));
              acc[4 * g] = lo_bf(qv.x) * eg - acc[4 * g]; acc[4 * g + 1] = hi_bf(qv.x) * eg - acc[4 * g + 1]; acc[4 * g + 2] = lo_bf(qv.y) * eg - acc[4 * g + 2]; acc[4 * g + 3] = hi_bf(qv.y) * eg - acc[4 * g + 3]; }
          ans_store(Qp + (ti * 4 + td) * 1024, acc, lane); }
      { const int ti = wave & 1, te = wave >> 1;
          f32x16 acc = zero16(); mm_lds<4>(acc, lds + L_AT + 32 * ti * AS_, AS_, lds + L_SOL + 32 * te * AS_, AS_, lane);
          v4u w0, w1; ans_pack(acc, w0, w1); const int eo = (ti * 4 + te) * 1024 + lane * 8;
          *(v4u*)yslot(Y, tok0, h, eo) = w0; *(v4u*)yslot(Y, tok0, h, eo + 512) = w1; }
      if (tid == 0) ((float*)(ws + WS_GL))[item] = __expf(gcs[63]);
    }
    WG_BAR();
}

constexpr int SC_RING = 16384, SC_SLOT = 32768;
struct ScanB { v4u bn[2]; float egl; };
__device__ __forceinline__ int scan_item(int bh, int n) { if (n > NCH - 1) n = NCH - 1; return ((bh >> 2) * NCH + n) * 4 + (bh & 3); }
__device__ __forceinline__ void scanb_load(ScanB& p, const unsigned char* ws, int bh, int n, int td, int te, int lane) {
    const int item = scan_item(bh, n);
    p.egl = ((const float*)(ws + WS_GL))[item];
    const bf16* Bs = (const bf16*)(ws + WS_BS) + (size_t)item * 16384 + (te * 4 + td) * 1024 + lane * 8;
    p.bn[0] = *(const v4u*)Bs; p.bn[1] = *(const v4u*)(Bs + 512);
}
__device__ __forceinline__ void scan_step(const ScanB& p, f32x16& acc, unsigned char* ws, LAS unsigned char* lds, int bh, int n, int cur, int td, int te, int lane) {
    const int item = scan_item(bh, n);
    v4u b0 = p.bn[0], b1 = p.bn[1]; float egl = p.egl;
    asm volatile("" : "+v"(egl)); asm volatile("" : "+v"(b0)); asm volatile("" : "+v"(b1));
    f32x16 bv16; ans_unpack(b0, b1, bv16);
#pragma unroll
    for (int r = 0; r < 16; ++r) acc[r] = acc[r] * egl + bv16[r];
    const LAS unsigned char* sb = lds + cur * 8192 + lane * 16;
    const LAS unsigned char* sa = lds + SC_RING + (n & 3) * SC_SLOT + td * 8192 + lane * 16;
    f32x16 acc2 = zero16();
#pragma unroll
    for (int q = 0; q < 8; q += 2) {
        const bf16x8 a0 = *(const LAS bf16x8*)(sa + 1024 * q), bv0 = *(const LAS bf16x8*)(sb + 1024 * q);
        const bf16x8 a1 = *(const LAS bf16x8*)(sa + 1024 * (q + 1)), bv1 = *(const LAS bf16x8*)(sb + 1024 * (q + 1));
        acc = __builtin_amdgcn_mfma_f32_32x32x16_bf16(a0, bv0, acc, 0, 0, 0); acc2 = __builtin_amdgcn_mfma_f32_32x32x16_bf16(a1, bv1, acc2, 0, 0, 0); }
#pragma unroll
    for (int r = 0; r < 16; ++r) acc[r] += acc2[r];
    v4u w0, w1; ans_pack(acc, w0, w1);
    LAS unsigned char* sn = lds + (cur ^ 1) * 8192 + td * 2048 + lane * 16;
    *(LAS v4u*)sn = w0; *(LAS v4u*)(sn + 1024) = w1;
    bf16* So = (bf16*)(ws + WS_BS) + (size_t)item * 16384 + (te * 4 + td) * 1024 + lane * 8;
    *(v4u*)So = w0; *(v4u*)(So + 512) = w1;
}
struct ScanA { bf16x8 a[8]; };
__device__ __forceinline__ void scana_load(ScanA& p, const unsigned char* ws, int bh, int n, int td, int lane) {
    const bf16* Ms = (const bf16*)(ws + WS_MS) + (size_t)scan_item(bh, n) * 16384 + td * 4096 + lane * 8;
#pragma unroll
    for (int q = 0; q < 8; ++q) p.a[q] = *(const bf16x8*)(Ms + 512 * q);
}
__device__ __forceinline__ void scana_put(const ScanA& p, LAS unsigned char* lds, int n, int td, int lane) {
    LAS unsigned char* d = lds + SC_RING + (n & 3) * SC_SLOT + td * 8192 + lane * 16;
#pragma unroll
    for (int q = 0; q < 8; ++q) *(LAS bf16x8*)(d + 1024 * q) = p.a[q];
}
__device__ __forceinline__ void dn_scan(const Args& a, LAS unsigned char* lds, int wg, int tid, int wave, int lane) {
    unsigned char* ws = a.ws;
    const int bh = wg & 7, te = wg >> 3, td = wave & 3;
    for (int u = tid; u < 2 * 8192 / 4; u += NTHR) ((LAS unsigned*)lds)[u] = 0u;
    if (wave < 4) {
        f32x16 acc = zero16();
        ScanB p0, p1, p2, p3, p4, p5, p6, p7;
        scanb_load(p0, ws, bh, 0, td, te, lane); scanb_load(p1, ws, bh, 1, td, te, lane); scanb_load(p2, ws, bh, 2, td, te, lane); scanb_load(p3, ws, bh, 3, td, te, lane);
        scanb_load(p4, ws, bh, 4, td, te, lane); scanb_load(p5, ws, bh, 5, td, te, lane); scanb_load(p6, ws, bh, 6, td, te, lane);
        WG_BAR();
#pragma unroll 1
        for (int n = 0; n < NCH; n += 8) {
            scanb_load(p7, ws, bh, n + 7, td, te, lane);  scan_step(p0, acc, ws, lds, bh, n, 0, td, te, lane); WG_BAR();
            scanb_load(p0, ws, bh, n + 8, td, te, lane);  scan_step(p1, acc, ws, lds, bh, n + 1, 1, td, te, lane); WG_BAR();
            scanb_load(p1, ws, bh, n + 9, td, te, lane);  scan_step(p2, acc, ws, lds, bh, n + 2, 0, td, te, lane); WG_BAR();
            scanb_load(p2, ws, bh, n + 10, td, te, lane); scan_step(p3, acc, ws, lds, bh, n + 3, 1, td, te, lane); WG_BAR();
            scanb_load(p3, ws, bh, n + 11, td, te, lane); scan_step(p4, acc, ws, lds, bh, n + 4, 0, td, te, lane); WG_BAR();
            scanb_load(p4, ws, bh, n + 12, td, te, lane); scan_step(p5, acc, ws, lds, bh, n + 5, 1, td, te, lane); WG_BAR();
            scanb_load(p5, ws, bh, n + 13, td, te, lane); scan_step(p6, acc, ws, lds, bh, n + 6, 0, td, te, lane); WG_BAR();
            scanb_load(p6, ws, bh, n + 14, td, te, lane); scan_step(p7, acc, ws, lds, bh, n + 7, 1, td, te, lane); WG_BAR();
        }
    } else {
        ScanA s0, s1, s2, s3;
        scana_load(s0, ws, bh, 0, td, lane); scana_load(s1, ws, bh, 1, td, lane); scana_load(s2, ws, bh, 2, td, lane);
        scana_put(s0, lds, 0, td, lane); scana_put(s1, lds, 1, td, lane); scana_put(s2, lds, 2, td, lane);
        scana_load(s3, ws, bh, 3, td, lane); scana_load(s0, ws, bh, 4, td, lane); scana_load(s1, ws, bh, 5, td, lane); scana_load(s2, ws, bh, 6, td, lane);
        WG_BAR();
#pragma unroll 1
        for (int n = 0; n < NCH; n += 4) {
            scana_put(s3, lds, n + 3, td, lane); scana_load(s3, ws, bh, n + 7, td, lane); WG_BAR();
            scana_put(s0, lds, n + 4, td, lane); scana_load(s0, ws, bh, n + 8, td, lane); WG_BAR();
            scana_put(s1, lds, n + 5, td, lane); scana_load(s1, ws, bh, n + 9, td, lane); WG_BAR();
            scana_put(s2, lds, n + 6, td, lane); scana_load(s2, ws, bh, n + 10, td, lane); WG_BAR();
        }
    }
}


__device__ __forceinline__ int dn_item_of(int c, int k, int G) {
    if ((G & 7) != 0 || NCH % (G >> 3) != 0) { const int it = c + k * G; return it < NITEM ? it : -1; }
    const int bh = c & 7, n = (c >> 3) + (G >> 3) * k; return n < NCH ? ((bh >> 2) * NCH + n) * 4 + (bh & 3) : -1;
}

struct OutPre { v4u o0, o1, z0, z1; bf16x8 av[8], bv[8]; };
__device__ __forceinline__ void out_load(OutPre& p, const Args& a, int item, int tid, int wave, int lane) {
    const unsigned char* ws = a.ws; const bf16* P = (const bf16*)(ws + WS_H); bf16* Y = (bf16*)(ws + WS_Y);
    const int h = item & 3, n = (item >> 2) & (NCH - 1), b = item >> 9; const int tok0 = b * T + n * 64;
    const int ti = wave & 1, te = wave >> 1;
    const v4u* zp = (const v4u*)(P + (size_t)(tok0 + (tid >> 3)) * NIN + 2560 + 128 * h + 16 * (tid & 7)); p.z0 = zp[0]; p.z1 = zp[1];
    { const int eo = (ti * 4 + te) * 1024 + lane * 8; p.o0 = *(const v4u*)yslot(Y, tok0, h, eo); p.o1 = *(const v4u*)yslot(Y, tok0, h, eo + 512); }
    if (n > 0) {
        const bf16* Qp = (const bf16*)(ws + WS_QP) + (size_t)item * 8192 + ti * 4096 + lane * 8;
        const bf16* Sp = (const bf16*)(ws + WS_BS) + (size_t)(item - 4) * 16384 + te * 4096 + lane * 8;
#pragma unroll
        for (int q = 0; q < 8; ++q) { p.av[q] = *(const bf16x8*)(Qp + 512 * q); p.bv[q] = *(const bf16x8*)(Sp + 512 * q); }
    }
}
__device__ __forceinline__ void dn_out_phase(const Args& a, LAS unsigned char* lds, int c, int G, int tid, int wave, int lane) {
    unsigned char* ws = a.ws; bf16* Y = (bf16*)(ws + WS_Y);
    int item = dn_item_of(c, 0, G); if (item < 0) return;
    OutPre p; out_load(p, a, item, tid, wave, lane);
    const int ti = wave & 1, te = wave >> 1, rr = lane & 31, hh = lane >> 5, e = 32 * te + rr;
    LAS float* of = (LAS float*)lds;
#pragma unroll 1
    for (int k = 0; item >= 0; ++k) {
        const int h = item & 3, n = (item >> 2) & (NCH - 1), b = item >> 9; const int tok0 = b * T + n * 64;
        const int nx = dn_item_of(c, k + 1, G);
        f32x16 acc; ans_unpack(p.o0, p.o1, acc);
        if (n > 0) {
#pragma unroll
            for (int q = 0; q < 8; ++q) acc = __builtin_amdgcn_mfma_f32_32x32x16_bf16(p.av[q], p.bv[q], acc, 0, 0, 0);
        }
        const v4u z0 = p.z0, z1 = p.z1;
        if (nx >= 0) out_load(p, a, nx, tid, wave, lane);
#pragma unroll
        for (int r = 0; r < 16; ++r) { const int i = 32 * ti + (r & 3) + 8 * (r >> 2) + 4 * hh; of[i * 132 + e] = acc[r]; }
        WG_BAR();
        { const int i = tid >> 3, e0 = 16 * (tid & 7);
          float v[16]; float sq = 0.f;
#pragma unroll
          for (int q = 0; q < 4; ++q) { const f32x4 t = *(const LAS f32x4*)(of + i * 132 + e0 + 4 * q); v[4 * q] = t[0]; v[4 * q + 1] = t[1]; v[4 * q + 2] = t[2]; v[4 * q + 3] = t[3]; sq += (t[0] * t[0] + t[1] * t[1]) + (t[2] * t[2] + t[3] * t[3]); }
          sq += __shfl_xor(sq, 1); sq += __shfl_xor(sq, 2); sq += __shfl_xor(sq, 4);
          const float rs = rsqrtf(sq * (1.0f / 128.0f) + EPS);
          const float zz[16] = { lo_bf(z0.x), hi_bf(z0.x), lo_bf(z0.y), hi_bf(z0.y), lo_bf(z0.z), hi_bf(z0.z), lo_bf(z0.w), hi_bf(z0.w), lo_bf(z1.x), hi_bf(z1.x), lo_bf(z1.y), hi_bf(z1.y), lo_bf(z1.z), hi_bf(z1.z), lo_bf(z1.w), hi_bf(z1.w) };
          const float* dw = a.in[14] + e0; float o[16];
#pragma unroll
          for (int q = 0; q < 16; ++q) o[q] = v[q] * rs * dw[q] * zz[q];
          v4u w0, w1; w0.x = pk2(o[0], o[1]); w0.y = pk2(o[2], o[3]); w0.z = pk2(o[4], o[5]); w0.w = pk2(o[6], o[7]); w1.x = pk2(o[8], o[9]); w1.y = pk2(o[10], o[11]); w1.z = pk2(o[12], o[13]); w1.w = pk2(o[14], o[15]);
          v4u* yp = (v4u*)(Y + (size_t)(tok0 + i) * D + 512 + 128 * h + e0); yp[0] = w0; yp[1] = w1; }
        WG_BAR();
        item = nx;
    }
}

constexpr int NPHASE = 10;
__global__ void __launch_bounds__(NTHR, 2) fwd_kernel(Args args) {
    extern __shared__ __attribute__((aligned(16))) unsigned char lds_raw[];
    LAS unsigned char* lds = (LAS unsigned char*)lds_raw;
    const int tid = threadIdx.x, lane = tid & 63, wave = __builtin_amdgcn_readfirstlane(tid >> 6);
    unsigned char* ws = args.ws; const int G = gridDim.x;
    const int lo = args.ph_lo, hi = args.ph_hi;
    float* ss = (float*)(ws + WS_CTL);
    bf16* XB = (bf16*)(ws + WS_XB); bf16* HB = (bf16*)(ws + WS_H); bf16* YB = (bf16*)(ws + WS_Y);
#define IN(k) (lo <= (k) && (k) < hi)
    volatile LAS unsigned* bst = (volatile LAS unsigned*)(lds + LDS_BYTES - 64);
    if (tid < 2) bst[tid] = 0u;
    __syncthreads();
    const XcdBarrier bar = xcd_barrier_post((unsigned*)(ws + WS_BAR), bst);
    if (lo < -1) cg::this_grid().sync();
#define SEAM(k) do { if (IN(k) && IN((k) + 1)) xcd_barrier(bar); } while (0)
    if (IN(0)) { p0_prologue(args, lds, wave, lane, 0, blockIdx.x * NWAVES + wave, G * NWAVES); }
    SEAM(0);
    if (IN(1)) { pg8::Gemm g{XB, (const bf16*)(ws + WS_WGU1), M, 2 * FF, D}; pg8::StaticOrder S; S.init(M, 2 * FF, G, (int)blockIdx.x);
        EpiSwiglu E{HB, ss}; pg8::gemm_phase<EpiSwiglu, pg8::StaticOrder, true, true>(lds, g, S, E);
        { const int nfull = (M / 256) * (2 * FF / 256) % G; if (nfull != 0 && (int)blockIdx.x >= nfull) p0_prologue(args, lds, wave, lane, 1, ((int)blockIdx.x - nfull) * NWAVES + wave, (G - nfull) * NWAVES);
          else if (nfull == 0) p0_prologue(args, lds, wave, lane, 1, blockIdx.x * NWAVES + wave, G * NWAVES); } }
    SEAM(1);
    if (IN(2)) { pg8::Gemm g{HB, (const bf16*)(ws + WS_WD1), M, D, FF}; pg8::StaticOrder S; S.init(M, D, G, (int)blockIdx.x);
        EpiResid E{args.in[0], args.out, XB, ss + M, 0.5f}; pg8::gemm_phase<EpiResid, pg8::StaticOrder, true, true>(lds, g, S, E); }
    SEAM(2);
    if (IN(3)) { pg8::Gemm g{XB, (const bf16*)(ws + WS_WIN), M, NIN, D}; pg8::StaticOrder S; S.init(M, NIN, G, (int)blockIdx.x);
        EpiProj E{HB, ss + M}; pg8::gemm_phase<EpiProj, pg8::StaticOrder, true, true>(lds, g, S, E);
        pex_rows(ws, wave, lane); }
    SEAM(3);
    if (IN(4)) { int cwh = -1; for (int k = 0, it = dn_item_of(blockIdx.x, 0, G); it >= 0; ++k) { const int nx = dn_item_of(blockIdx.x, k + 1, G); dn_prep_item(args, lds, it, tid, wave, lane, cwh, nx); it = nx; } }
    SEAM(4);
    if (IN(5)) {
        if (blockIdx.x < 32) dn_scan(args, lds, blockIdx.x, tid, wave, lane);
        else { const int c = blockIdx.x - 32, NC = G - 32;
            for (int it = c; it < M / 64; it += NC) gmlp_item(args, lds, it, tid, wave, lane);
            const int nd = M / 64 - NC;
            if (c >= nd) p0_prologue(args, lds, wave, lane, 2, (c - nd) * NWAVES + wave, (NC - nd) * NWAVES); } }
    SEAM(5);
    if (IN(6)) { dn_out_phase(args, lds, blockIdx.x, G, tid, wave, lane); }
    SEAM(6);
    if (IN(7)) { pg8::Gemm g{YB, (const bf16*)(ws + WS_WOUT), M, D, D}; pg8::StaticOrder S; S.init(M, D, G, (int)blockIdx.x);
        EpiResid E{args.out, args.out, XB, ss + 2 * M, 1.0f}; pg8::gemm_phase<EpiResid, pg8::StaticOrder, true, true>(lds, g, S, E); }
    SEAM(7);
    if (IN(8)) { pg8::Gemm g{XB, (const bf16*)(ws + WS_WGU2), M, 2 * FF, D}; pg8::StaticOrder S; S.init(M, 2 * FF, G, (int)blockIdx.x);
        EpiSwiglu E{HB, ss + 2 * M}; pg8::gemm_phase<EpiSwiglu, pg8::StaticOrder, true, true>(lds, g, S, E); }
    SEAM(8);
    if (IN(9)) { pg8::Gemm g{HB, (const bf16*)(ws + WS_WD2), M, D, FF}; pg8::StaticOrder S; S.init(M, D, G, (int)blockIdx.x);
        EpiFinal E{args.out, args.out, ss + 3 * M, (unsigned*)(ws + WS_PCNT), args.in[20], 0.5f}; pg8::gemm_phase<EpiFinal, pg8::StaticOrder, true, true>(lds, g, S, E); }
#undef IN
#undef SEAM
}

#ifndef MK_ONE_LAUNCH
#define MK_ONE_LAUNCH 1
#endif
extern "C" void kernel_launch(void* const* d_in, const int* in_sizes, int n_in, void* d_out, int out_size, void* d_ws, size_t ws_size, hipStream_t stream) {
    static int grid = 0;
    if (grid == 0) {
        if (n_in != 21 || out_size != M * D || ws_size < WS_END) { fprintf(stderr, "kernel_launch: unexpected shapes (n_in %d out %d ws %zu)\n", n_in, out_size, ws_size); grid = -1; return; }
        if (hipFuncSetAttribute((const void*)fwd_kernel, hipFuncAttributeMaxDynamicSharedMemorySize, LDS_BYTES) != hipSuccess) { fprintf(stderr, "kernel_launch: hipFuncSetAttribute failed\n"); grid = -1; return; }
        int dev = 0, cus = 0, per_cu = 0; hipGetDevice(&dev); hipDeviceGetAttribute(&cus, hipDeviceAttributeMultiprocessorCount, dev);
        hipOccupancyMaxActiveBlocksPerMultiprocessor(&per_cu, (const void*)fwd_kernel, NTHR, LDS_BYTES);
        if (per_cu < 1) { fprintf(stderr, "kernel_launch: occupancy query says %d blocks per CU\n", per_cu); per_cu = 1; }
        (void)hipGetLastError();
        grid = cus;
    }
    if (grid < 0) return;
    hipMemsetAsync((char*)d_ws + WS_CTL, 0, CTL_ZERO_BYTES, stream);
    Args a{};
    for (int i = 0; i < 21; ++i) a.in[i] = (const float*)d_in[i];
    a.out = (float*)d_out; a.ws = (unsigned char*)d_ws;
#if MK_ONE_LAUNCH
    a.ph_lo = 0; a.ph_hi = NPHASE;
    void* kargs[] = { &a };
    hipError_t e = hipLaunchCooperativeKernel((const void*)fwd_kernel, dim3(grid), dim3(NTHR), kargs, LDS_BYTES, stream);
    if (e != hipSuccess) fprintf(stderr, "cooperative launch failed: %s (grid %d)\n", hipGetErrorString(e), grid);
#else
    for (int p = 0; p < NPHASE; ++p) { a.ph_lo = p; a.ph_hi = p + 1; hipLaunchKernelGGL(fwd_kernel, dim3(grid), dim3(NTHR), LDS_BYTES, stream, a); }
#endif
}
```

```cpp
#include <hip/hip_runtime.h>
#include <hip/hip_cooperative_groups.h>
#include <cstdio>
#include <cstdint>
namespace cg = cooperative_groups;
namespace pg8 {
#define PG8_LAS __attribute__((address_space(3)))
typedef unsigned short bf16_t;
typedef short bf16x8 __attribute__((ext_vector_type(8)));
typedef float f32x4 __attribute__((ext_vector_type(4)));
typedef unsigned u32x4 __attribute__((ext_vector_type(4)));
constexpr int BM = 256, BK = 64, HALF = 128, HTB = HALF * BK * 2  , STAGE_BYTES = 8 * HTB, NXCD = 8, WGM = 8;

__host__ __device__ __forceinline__ int lds_byte(int r, int c) { const int st = (r >> 4) * 2 + (c >> 5), rr = r & 15, cc = c & 31, ob = rr * 64 + cc * 2; return st * 1024 + (ob ^ (((ob >> 9) & 1) << 5)); }
__host__ __device__ __forceinline__ void stage_rc(int b, int& R, int& C) { const int st = b / 1024, sb = b % 1024, swz = sb ^ (((sb >> 9) & 1) << 5); R = (st >> 1) * 16 + swz / 64; C = (st & 1) * 32 + (swz % 64) / 2; }
__host__ __device__ __forceinline__ int perm32(int rho) { const int n = rho >> 4, i = rho & 15; return 8 * (i >> 2) + 4 * n + (i & 3); }

struct Unit { int pm, pn; };
struct Gemm { const bf16_t* A; const bf16_t* Bt; int M, N, K; };

struct StaticOrder {
    int nM, nN, nwg, G, c;
    __host__ __device__ void init(int M, int N, int G_, int c_) { nM = M / BM; nN = N / BM; nwg = nM * nN; G = G_; c = c_; }
    __host__ __device__ bool next(int i, Unit& u) const {
        const long L = (long)i * G + c; if (L >= nwg) return false;
        int wgid = (int)L; { const int q = nwg / NXCD, r = nwg % NXCD, xcd = wgid % NXCD, off = wgid / NXCD; wgid = (xcd < r ? xcd * (q + 1) : r * (q + 1) + (xcd - r) * q) + off; }
        const int nig = WGM * nN, gid = wgid / nig, fm = gid * WGM, gsz = (nM - fm) < WGM ? (nM - fm) : WGM;
        u.pm = fm + ((wgid % nig) % gsz); u.pn = (wgid % nig) / gsz; return true;
    }
    __device__ __forceinline__ void a_ready(const Unit&) const {}
    __device__ __forceinline__ void done(const Unit&) const {}
};

__device__ __forceinline__ unsigned cvt_pk_bf16(float lo, float hi) { unsigned r; asm volatile("v_cvt_pk_bf16_f32 %0, %1, %2" : "=v"(r) : "v"(lo), "v"(hi)); return r; }

template <class Epi, class Sched, bool ALIGN_EPI = false, bool SP2 = false>
__device__ __forceinline__ void gemm_phase(PG8_LAS unsigned char* lds, const Gemm g, const Sched& S, const Epi& E) {
    const int tid = threadIdx.x, wid = __builtin_amdgcn_readfirstlane(tid >> 6), lane = tid & 63, wr = wid >> 2, wc = wid & 3, fr = lane & 15, fq = lane >> 4;
    const int K = g.K, nt = K / BK;
    unsigned voffA[2], voffB[2];
#pragma unroll
    for (int i = 0; i < 2; ++i) { int R, C; stage_rc(tid * 16 + i * 8192, R, C); const int Rb = Epi::PERM ? ((R & ~31) + perm32(R & 31)) : R;
        voffA[i] = (unsigned)(R * K + C) * 2u; voffB[i] = (unsigned)(Rb * K + C) * 2u; }
    const size_t kstep = (size_t)(BK * 2);
    const size_t hstep = (size_t)HALF * K * 2;
    const size_t tstep = 2 * hstep;
    const unsigned ldsw = (unsigned)wid * 1024u;
    const int aoff = lds_byte(wr * 64 + fr, fq * 8), boff = lds_byte(wc * 32 + fr, fq * 8);
#define PG8_SA(b, h) (((b) * 2 + (h)) * HTB)
#define PG8_SB(b, h) ((4 + (b) * 2 + (h)) * HTB)
#define PG8_STAGE(bufoff, gbase, voff) do { _Pragma("unroll") for (int _i = 0; _i < 2; ++_i) \
        __builtin_amdgcn_global_load_lds((const unsigned*)((const char*)(gbase) + (voff)[_i]), (PG8_LAS unsigned*)(lds + (bufoff) + ldsw + _i * 8192), 16, 0, 0); } while (0)
#define PG8_LDA(dst, b, h) do { _Pragma("unroll") for (int m = 0; m < 4; ++m) _Pragma("unroll") for (int k = 0; k < 2; ++k) dst[m][k] = *(const PG8_LAS bf16x8*)(lds + PG8_SA(b, h) + aoff + m * 2048 + k * 1024); } while (0)
#define PG8_LDB(dst, b, h) do { _Pragma("unroll") for (int n = 0; n < 2; ++n) _Pragma("unroll") for (int k = 0; k < 2; ++k) dst[n][k] = *(const PG8_LAS bf16x8*)(lds + PG8_SB(b, h) + boff + n * 2048 + k * 1024); } while (0)
#define PG8_MMA(ai, bj, At, Bt) do { __builtin_amdgcn_s_setprio(1); _Pragma("unroll") for (int m = 0; m < 4; ++m) _Pragma("unroll") for (int n = 0; n < 2; ++n) _Pragma("unroll") for (int k = 0; k < 2; ++k) \
        acc[ai][bj][m][n] = __builtin_amdgcn_mfma_f32_16x16x32_bf16(Bt[n][k], At[m][k], acc[ai][bj][m][n], 0, 0, 0); __builtin_amdgcn_s_setprio(0); } while (0)
#define PG8_WAIT_V(n) asm volatile("s_waitcnt vmcnt(" #n ")" ::: "memory")
#define PG8_WAIT_L(n) asm volatile("s_waitcnt lgkmcnt(" #n ")" ::: "memory")
#define PG8_BAR __builtin_amdgcn_s_barrier()
#define PG8_SCHED __builtin_amdgcn_sched_barrier(0)
    Unit cur, nxt; int ui = 0;
    if (!S.next(0, cur)) return;
    f32x4 acc[2][2][4][2];
#pragma unroll
    for (int a = 0; a < 2; ++a)
#pragma unroll
        for (int b = 0; b < 2; ++b)
#pragma unroll
            for (int m = 0; m < 4; ++m)
#pragma unroll
                for (int n = 0; n < 2; ++n) acc[a][b][m][n] = (f32x4){0.f, 0.f, 0.f, 0.f};
    bf16x8 At[4][2], B0[2][2], B1[2][2];
    const char* cA = (const char*)g.A + (size_t)cur.pm * tstep; const char* cB = (const char*)g.Bt + (size_t)cur.pn * tstep;
    S.a_ready(cur);
    if constexpr (SP2) {
        PG8_STAGE(PG8_SB(0, 0), cB, voffB); PG8_STAGE(PG8_SB(0, 1), cB + hstep, voffB); PG8_STAGE(PG8_SA(0, 0), cA, voffA); PG8_STAGE(PG8_SA(0, 1), cA + hstep, voffA);
        if (wr == 1) PG8_BAR;
        PG8_WAIT_V(2); PG8_BAR;
        PG8_STAGE(PG8_SB(1, 0), cB + kstep, voffB); PG8_STAGE(PG8_SA(1, 0), cA + kstep, voffA); PG8_STAGE(PG8_SB(1, 1), cB + hstep + kstep, voffB);
        PG8_WAIT_V(6); PG8_BAR;
    } else {
        PG8_STAGE(PG8_SB(0, 0), cB, voffB); PG8_STAGE(PG8_SA(0, 0), cA, voffA); PG8_STAGE(PG8_SB(0, 1), cB + hstep, voffB); PG8_STAGE(PG8_SA(0, 1), cA + hstep, voffA);
        if (wr == 1) PG8_BAR;
        PG8_WAIT_V(4); PG8_BAR;
        PG8_STAGE(PG8_SB(1, 0), cB + kstep, voffB); PG8_STAGE(PG8_SA(1, 0), cA + kstep, voffA); PG8_STAGE(PG8_SB(1, 1), cB + hstep + kstep, voffB);
        PG8_WAIT_V(6); PG8_BAR;
    }
    for (;;) {
        const bool has_next = S.next(ui + 1, nxt);
        const char* nA = has_next ? (const char*)g.A + (size_t)nxt.pm * tstep : cA; const char* nB = has_next ? (const char*)g.Bt + (size_t)nxt.pn * tstep : cB;
        for (int t = 0; t < nt; t += 2) {
            const bool last = (t == nt - 2);
            const char* a1 = cA + (size_t)(t + 1) * kstep;
            const char* a2 = last ? nA : cA + (size_t)(t + 2) * kstep; const char* b2 = last ? nB : cB + (size_t)(t + 2) * kstep;
            const char* a3 = a2 + kstep; const char* b3 = b2 + kstep;
            if (last && has_next) S.a_ready(nxt);
            if constexpr (SP2) {
            PG8_LDB(B0, 0, 0); PG8_LDB(B1, 0, 1); PG8_SCHED; PG8_LDA(At, 0, 0); PG8_STAGE(PG8_SA(1, 1), a1 + hstep, voffA);
            PG8_WAIT_V(8); PG8_WAIT_L(0); PG8_BAR; PG8_MMA(0, 0, At, B0); PG8_MMA(0, 1, At, B1); PG8_BAR; PG8_SCHED;
            PG8_LDA(At, 0, 1); PG8_STAGE(PG8_SB(0, 0), b2, voffB); PG8_STAGE(PG8_SB(0, 1), b2 + hstep, voffB); PG8_STAGE(PG8_SA(0, 0), a2, voffA);
            PG8_WAIT_V(8); PG8_WAIT_L(0); PG8_BAR; PG8_MMA(1, 0, At, B0); PG8_MMA(1, 1, At, B1); PG8_BAR; PG8_SCHED;
            PG8_LDB(B0, 1, 0); PG8_LDB(B1, 1, 1); PG8_SCHED; PG8_LDA(At, 1, 0); PG8_STAGE(PG8_SA(0, 1), a2 + hstep, voffA);
            PG8_WAIT_V(8); PG8_WAIT_L(0); PG8_BAR; PG8_MMA(0, 0, At, B0); PG8_MMA(0, 1, At, B1); PG8_BAR; PG8_SCHED;
            PG8_LDA(At, 1, 1); PG8_STAGE(PG8_SB(1, 0), b3, voffB); PG8_STAGE(PG8_SB(1, 1), b3 + hstep, voffB); PG8_STAGE(PG8_SA(1, 0), a3, voffA);
            PG8_WAIT_V(8); PG8_WAIT_L(0); PG8_BAR; PG8_MMA(1, 0, At, B0); PG8_MMA(1, 1, At, B1); PG8_BAR; PG8_SCHED;
            } else {
            PG8_LDB(B0, 0, 0); PG8_SCHED; PG8_LDA(At, 0, 0); PG8_STAGE(PG8_SA(1, 1), a1 + hstep, voffA);
            PG8_WAIT_L(8); PG8_BAR; PG8_WAIT_L(0); PG8_MMA(0, 0, At, B0); PG8_BAR; PG8_SCHED;
            PG8_LDB(B1, 0, 1); PG8_STAGE(PG8_SB(0, 0), b2, voffB);
            PG8_BAR; PG8_WAIT_L(0); PG8_MMA(0, 1, At, B1); PG8_BAR;
            PG8_LDA(At, 0, 1); PG8_STAGE(PG8_SA(0, 0), a2, voffA);
            PG8_BAR; PG8_WAIT_L(0); PG8_MMA(1, 0, At, B0); PG8_BAR; PG8_SCHED;
            PG8_STAGE(PG8_SB(0, 1), b2 + hstep, voffB);
            PG8_WAIT_V(6); PG8_BAR; PG8_MMA(1, 1, At, B1); PG8_BAR;
            PG8_LDB(B0, 1, 0); PG8_SCHED; PG8_LDA(At, 1, 0); PG8_STAGE(PG8_SA(0, 1), a2 + hstep, voffA);
            PG8_WAIT_L(8); PG8_BAR; PG8_WAIT_L(0); PG8_MMA(0, 0, At, B0); PG8_BAR; PG8_SCHED;
            PG8_LDB(B1, 1, 1); PG8_STAGE(PG8_SB(1, 0), b3, voffB);
            PG8_BAR; PG8_WAIT_L(0); PG8_MMA(0, 1, At, B1); PG8_BAR;
            PG8_LDA(At, 1, 1); PG8_STAGE(PG8_SA(1, 0), a3, voffA);
            PG8_BAR; PG8_WAIT_L(0); PG8_MMA(1, 0, At, B0); PG8_BAR; PG8_SCHED;
            PG8_STAGE(PG8_SB(1, 1), b3 + hstep, voffB);
            PG8_WAIT_V(6); PG8_BAR; PG8_MMA(1, 1, At, B1); PG8_BAR;
            }
        }
        if constexpr (ALIGN_EPI) { if (wr == 0) PG8_BAR; }
        if constexpr (!Epi::AFTER_DRAIN) { E(acc, cur, wr, wc, fr, fq); S.done(cur); }
        if (!has_next) break;
#pragma unroll
        for (int a = 0; a < 2; ++a)
#pragma unroll
            for (int b = 0; b < 2; ++b)
#pragma unroll
                for (int m = 0; m < 4; ++m)
#pragma unroll
                    for (int n = 0; n < 2; ++n) acc[a][b][m][n] = (f32x4){0.f, 0.f, 0.f, 0.f};
        cur = nxt; cA = nA; cB = nB; ++ui;
        if constexpr (ALIGN_EPI) { if (wr == 1) PG8_BAR; }
    }
    PG8_WAIT_V(0);
    if constexpr (!ALIGN_EPI) { if (wr == 0) PG8_BAR; }
    PG8_BAR;
    if constexpr (Epi::AFTER_DRAIN) { E.fused(acc, cur, wr, wc, fr, fq, lds, wid, lane); S.done(cur); }
#undef PG8_SA
#undef PG8_SB
#undef PG8_STAGE
#undef PG8_LDA
#undef PG8_LDB
#undef PG8_MMA
#undef PG8_WAIT_V
#undef PG8_WAIT_L
#undef PG8_BAR
#undef PG8_SCHED
}
}

#define LAS __attribute__((address_space(3)))
typedef unsigned short bf16;
typedef unsigned v4u __attribute__((ext_vector_type(4)));
typedef unsigned v2u __attribute__((ext_vector_type(2)));
typedef float f32x4 __attribute__((ext_vector_type(4)));
typedef float f32x16 __attribute__((ext_vector_type(16)));
typedef short bf16x8 __attribute__((ext_vector_type(8)));

constexpr int NWAVES = 8, NTHR = 512;
constexpr int BATCH = 2, T = 8192, D = 1024, M = BATCH * T, FF = 2816, NIN = 3072, DIN = 3080;
constexpr int NCH = T / 64, NITEM = BATCH * NCH * 4;
constexpr float EPS = 1e-6f;
constexpr size_t MiB = 1u << 20;
constexpr size_t WS_CTL = 0, CTL_ZERO_BYTES = 288 * 1024;
constexpr size_t WS_PCNT = 272 * 1024;
constexpr size_t WS_BAR = 256 * 1024;
constexpr size_t WS_WOUT = 1 * MiB, WS_WGU2 = 3 * MiB, WS_WD2 = 14 * MiB;
constexpr size_t WS_WEX = 19 * MiB + 512 * 1024, WS_GL = WS_WEX + 64 * 1024, WS_PEX = 20 * MiB;
constexpr size_t WS_WGU1 = 20 * MiB + 512 * 1024, WS_WD1 = 31 * MiB + 512 * 1024, WS_WIN = 37 * MiB;
constexpr size_t WS_XB = 44 * MiB;
constexpr size_t WS_MS = WS_XB;
constexpr size_t WS_H = 76 * MiB;
constexpr size_t WS_Y = 172 * MiB;
constexpr size_t WS_BS = 204 * MiB;
constexpr size_t WS_QP = 236 * MiB;
constexpr size_t WS_END = 252 * MiB;
constexpr int LDS_BYTES = 155648;

__device__ __forceinline__ float bf2f(unsigned short v) { return __uint_as_float(((unsigned)v) << 16); }
__device__ __forceinline__ float lo_bf(unsigned w) { return __uint_as_float(w << 16); }
__device__ __forceinline__ float hi_bf(unsigned w) { return __uint_as_float(w & 0xffff0000u); }
typedef float f32x2_t __attribute__((ext_vector_type(2)));
typedef __bf16 bf16x2_t __attribute__((ext_vector_type(2)));
__device__ __forceinline__ unsigned pk2(float lo, float hi) { const f32x2_t v = {lo, hi}; const bf16x2_t b = __builtin_convertvector(v, bf16x2_t); return __builtin_bit_cast(unsigned, b); }
__device__ __forceinline__ float sigm(float x) { return __builtin_amdgcn_rcpf(1.f + __expf(-x)); }
__device__ __forceinline__ float silu_(float x) { return x * sigm(x); }
__device__ __forceinline__ void sigm2(float x0, float x1, float& s0, float& s1) {
    const float a = 1.f + __expf(-fmaxf(x0, -30.f)), b = 1.f + __expf(-fmaxf(x1, -30.f)); const float r = __builtin_amdgcn_rcpf(a * b); s0 = b * r; s1 = a * r;
}
__device__ __forceinline__ float gelu_(float x) { const float u = 0.7978845608028654f * (x + 0.044715f * x * x * x); return x * sigm(2.f * u); }
__device__ __forceinline__ float wave_sum(float v) {
#pragma unroll
    for (int o = 1; o < 64; o <<= 1) v += __shfl_xor(v, o);
    return v;
}
#define LDS_WAIT() asm volatile("s_waitcnt lgkmcnt(0)" ::: "memory")
#define WG_BAR() do { asm volatile("s_waitcnt lgkmcnt(0)" ::: "memory"); __builtin_amdgcn_s_barrier(); asm volatile("" ::: "memory"); } while (0)

template <int KS> __device__ __forceinline__ void mm_lds(f32x16& acc, const LAS unsigned char* a, int aStride, const LAS unsigned char* b, int bStride, int lane) {
    const int r = lane & 31, h = lane >> 5;
    const LAS unsigned char* ap = a + r * aStride + h * 16; const LAS unsigned char* bp = b + r * bStride + h * 16;
#pragma unroll
    for (int ks = 0; ks < KS; ++ks) {
        const bf16x8 av = *(const LAS bf16x8*)(ap + ks * 32); const bf16x8 bv = *(const LAS bf16x8*)(bp + ks * 32);
        acc = __builtin_amdgcn_mfma_f32_32x32x16_bf16(av, bv, acc, 0, 0, 0);
    }
}
__device__ __forceinline__ f32x16 zero16() { f32x16 z;
#pragma unroll
    for (int i = 0; i < 16; ++i) z[i] = 0.f;
    return z; }


__device__ __forceinline__ void ans_pack(const f32x16& v, v4u& w0, v4u& w1) {
    w0.x = pk2(v[0], v[1]); w0.y = pk2(v[2], v[3]); w0.z = pk2(v[4], v[5]); w0.w = pk2(v[6], v[7]);
    w1.x = pk2(v[8], v[9]); w1.y = pk2(v[10], v[11]); w1.z = pk2(v[12], v[13]); w1.w = pk2(v[14], v[15]);
}
__device__ __forceinline__ void ans_unpack(const v4u& w0, const v4u& w1, f32x16& v) {
    v[0] = lo_bf(w0.x); v[1] = hi_bf(w0.x); v[2] = lo_bf(w0.y); v[3] = hi_bf(w0.y); v[4] = lo_bf(w0.z); v[5] = hi_bf(w0.z); v[6] = lo_bf(w0.w); v[7] = hi_bf(w0.w);
    v[8] = lo_bf(w1.x); v[9] = hi_bf(w1.x); v[10] = lo_bf(w1.y); v[11] = hi_bf(w1.y); v[12] = lo_bf(w1.z); v[13] = hi_bf(w1.z); v[14] = lo_bf(w1.w); v[15] = hi_bf(w1.w);
}
__device__ __forceinline__ void ans_store(bf16* tile, const f32x16& v, int lane) { v4u w0, w1; ans_pack(v, w0, w1); *(v4u*)(tile + lane * 8) = w0; *(v4u*)(tile + 512 + lane * 8) = w1; }
__device__ __forceinline__ bf16* yslot(bf16* Y, int tok0, int h, int eo) { return Y + (size_t)(tok0 + (eo >> 7)) * D + 512 + 128 * h + (eo & 127); }

#define XB_TMO      128
#define XB_XCNT(j)  (256  + 64 * (j))
#define XB_XSUB(j)  (1280 + 64 * (j))
#define XB_XGEN(j)  (2304 + 64 * (j))
#define XB_TOP      3328
#define XB_TOPGEN   3392
#define XCD_BAR_WORDS 3456
#define XB_SPIN_CAP (1u << 18)

__device__ __forceinline__ unsigned xb_ld(unsigned* p)              { return __hip_atomic_load(p, __ATOMIC_RELAXED, __HIP_MEMORY_SCOPE_AGENT); }
__device__ __forceinline__ unsigned xb_add(unsigned* p, unsigned v) { return __hip_atomic_fetch_add(p, v, __ATOMIC_RELAXED, __HIP_MEMORY_SCOPE_AGENT); }
__device__ __forceinline__ unsigned xb_xcc_id() { return (unsigned)__builtin_amdgcn_s_getreg((3 << 11) | 20) & 0xFu; }
#define XB_SPIN(cond, bar) do { unsigned _sp = 0; while (cond) { __builtin_amdgcn_s_sleep(1); \
    if ((++_sp & 255u) == 0u) { if (xb_ld(&(bar)[XB_TMO])) break; if (_sp > XB_SPIN_CAP) { atomicAdd(&(bar)[XB_TMO], 1u); break; } } } } while (0)

struct XcdBarrier {
    unsigned* bar; unsigned x;
    volatile LAS unsigned* st;
};

__device__ __forceinline__ XcdBarrier xcd_barrier_post(unsigned* bar, volatile LAS unsigned* st) {
    XcdBarrier b; b.bar = bar; b.x = xb_xcc_id(); b.st = st;
    if (threadIdx.x == 0) (void)xb_add(&bar[XB_XCNT(b.x)], 1u);
    return b;
}
__device__ __forceinline__ void xcd_barrier_complete(unsigned* bar, unsigned x, unsigned& nloc, unsigned& nx) {
    const unsigned G = gridDim.x * gridDim.y * gridDim.z;
    unsigned sum, cnt, mine, sp = 0u;
    for (;;) {
        sum = 0u; cnt = 0u; mine = 0u;
#pragma unroll
        for (unsigned j = 0; j < 16; ++j) { const unsigned c = xb_ld(&bar[XB_XCNT(j)]); sum += c; cnt += (c > 0u) ? 1u : 0u; mine = (j == x) ? c : mine; }
        if (sum == G) break;
        __builtin_amdgcn_s_sleep(1);
        if ((++sp & 255u) == 0u) { if (xb_ld(&bar[XB_TMO])) break; if (sp > XB_SPIN_CAP) { atomicAdd(&bar[XB_TMO], 1u); break; } }
    }
    nloc = mine > 0u ? mine : 1u; nx = cnt > 0u ? cnt : 1u;
}

__device__ __forceinline__ void xcd_barrier(const XcdBarrier& b) {
    asm volatile("s_waitcnt vmcnt(0)" ::: "memory");
    __syncthreads();
    if (threadIdx.x == 0) {
        unsigned* bar = b.bar;
        __builtin_amdgcn_s_waitcnt(0);
        unsigned nloc = b.st[0], nx = b.st[1];
        if (nloc == 0u) { xcd_barrier_complete(bar, b.x, nloc, nx); b.st[0] = nloc; b.st[1] = nx; }
        const unsigned old = xb_add(&bar[XB_XSUB(b.x)], 1u);
        const unsigned gen = old / nloc;
        if (old + 1u == (gen + 1u) * nloc) {
            __builtin_amdgcn_fence(__ATOMIC_RELEASE, "agent");
            asm volatile("s_waitcnt vmcnt(0)" ::: "memory");
            const unsigned og = xb_add(&bar[XB_TOP], 1u);
            const unsigned tg = og / nx;
            if (og + 1u == (tg + 1u) * nx) xb_add(&bar[XB_TOPGEN], 1u);
            else XB_SPIN(xb_ld(&bar[XB_TOPGEN]) == tg, bar);
            __builtin_amdgcn_fence(__ATOMIC_ACQUIRE, "agent");
            xb_add(&bar[XB_XGEN(b.x)], 1u);
            asm volatile("s_waitcnt vmcnt(0)" ::: "memory");
        } else {
            XB_SPIN(xb_ld(&bar[XB_XGEN(b.x)]) == gen, bar);
            __builtin_amdgcn_fence(__ATOMIC_ACQUIRE, "agent");
            asm volatile("s_waitcnt vmcnt(0)" ::: "memory");
        }
    }
    __syncthreads();
}


using pg8::Unit;
struct EpiSwiglu {
    static constexpr bool PERM = true, AFTER_DRAIN = false;
    bf16* Hd; const float* ss;
    __device__ __forceinline__ void operator()(const f32x4 (&acc)[2][2][4][2], const Unit& u, int wr, int wc, int fr, int fq) const {
        const int row0 = u.pm * 256 + wr * 64 + fr, col0 = u.pn * 128 + wc * 32 + 8 * fq;
#pragma unroll
        for (int ai = 0; ai < 2; ++ai)
#pragma unroll
            for (int m = 0; m < 4; ++m) {
                const int row = row0 + ai * 128 + m * 16; const float rs = rsqrtf(ss[row] * (1.0f / D) + EPS);
                float hv[8];
#pragma unroll
                for (int n = 0; n < 2; ++n)
#pragma unroll
                    for (int q = 0; q < 4; q += 2) { const float g0 = acc[ai][0][m][n][q] * rs, g1 = acc[ai][0][m][n][q + 1] * rs, u0 = acc[ai][1][m][n][q] * rs, u1 = acc[ai][1][m][n][q + 1] * rs;
                        float s0, s1; sigm2(g0, g1, s0, s1); hv[4 * n + q] = g0 * s0 * u0; hv[4 * n + q + 1] = g1 * s1 * u1; }
                v4u w; w.x = pk2(hv[0], hv[1]); w.y = pk2(hv[2], hv[3]); w.z = pk2(hv[4], hv[5]); w.w = pk2(hv[6], hv[7]);
                *(v4u*)(Hd + (size_t)row * FF + col0) = w;
            }
    }
};
struct EpiResid {
    static constexpr bool PERM = false, AFTER_DRAIN = false;
    const float* base; float* out; bf16* xb; float* ss; float alpha;
    __device__ __forceinline__ void operator()(const f32x4 (&acc)[2][2][4][2], const Unit& u, int wr, int wc, int fr, int fq) const {
        const int row0 = u.pm * 256 + wr * 64 + fr, col0 = u.pn * 256 + wc * 32 + 4 * fq;
#pragma unroll
        for (int ai = 0; ai < 2; ++ai) {
            f32x4 bv[4][2][2];
#pragma unroll
            for (int m = 0; m < 4; ++m)
#pragma unroll
                for (int bj = 0; bj < 2; ++bj)
#pragma unroll
                    for (int n = 0; n < 2; ++n) bv[m][bj][n] = *(const f32x4*)(base + (size_t)(row0 + ai * 128 + m * 16) * D + col0 + bj * 128 + n * 16);
            asm volatile("" ::: "memory");
#pragma unroll
            for (int m = 0; m < 4; ++m) {
                const int row = row0 + ai * 128 + m * 16; float s = 0.f;
#pragma unroll
                for (int bj = 0; bj < 2; ++bj)
#pragma unroll
                    for (int n = 0; n < 2; ++n) {
                        const size_t off = (size_t)row * D + col0 + bj * 128 + n * 16;
                        const f32x4 v = bv[m][bj][n] + acc[ai][bj][m][n] * alpha;
                        *(f32x4*)(out + off) = v; s += (v[0] * v[0] + v[1] * v[1]) + (v[2] * v[2] + v[3] * v[3]);
                        if (xb) { v2u w; w.x = pk2(v[0], v[1]); w.y = pk2(v[2], v[3]); *(v2u*)(xb + off) = w; }
                    }
                s += __shfl_xor(s, 16); s += __shfl_xor(s, 32);
                if (fq == 0) atomicAdd(ss + row, s);
            }
        }
    }
};
struct EpiFinal {
    static constexpr bool PERM = false, AFTER_DRAIN = false;
    const float* base; float* out; float* ss; unsigned* cnt; const float* fn; float alpha;
    __device__ __forceinline__ void operator()(const f32x4 (&acc_)[2][2][4][2], const Unit& u, int wr, int wc, int fr, int fq) const {
        f32x4 (&acc)[2][2][4][2] = const_cast<f32x4 (&)[2][2][4][2]>(acc_);
        const int row0 = u.pm * 256 + wr * 64 + fr, col0 = u.pn * 256 + wc * 32 + 4 * fq;
#pragma unroll
        for (int ai = 0; ai < 2; ++ai) {
            f32x4 bv[4][2][2];
#pragma unroll
            for (int m = 0; m < 4; ++m)
#pragma unroll
                for (int bj = 0; bj < 2; ++bj)
#pragma unroll
                    for (int n = 0; n < 2; ++n) bv[m][bj][n] = *(const f32x4*)(base + (size_t)(row0 + ai * 128 + m * 16) * D + col0 + bj * 128 + n * 16);
#pragma unroll
            for (int m = 0; m < 4; ++m) { float s = 0.f;
#pragma unroll
                for (int bj = 0; bj < 2; ++bj)
#pragma unroll
                    for (int n = 0; n < 2; ++n) { const f32x4 v = bv[m][bj][n] + acc[ai][bj][m][n] * alpha; acc[ai][bj][m][n] = v; s += (v[0] * v[0] + v[1] * v[1]) + (v[2] * v[2] + v[3] * v[3]); }
                s += __shfl_xor(s, 16); s += __shfl_xor(s, 32);
                if (fq == 0) atomicAdd(ss + row0 + ai * 128 + m * 16, s);
            }
        }
        asm volatile("s_waitcnt vmcnt(0)" ::: "memory");
        __builtin_amdgcn_s_barrier(); asm volatile("" ::: "memory");
        if (threadIdx.x == 0) {
            unsigned* c = cnt + 64 * u.pm;
            __hip_atomic_fetch_add(c, 1u, __ATOMIC_RELAXED, __HIP_MEMORY_SCOPE_AGENT);
            unsigned spins = 0;
            while (__hip_atomic_load(c, __ATOMIC_RELAXED, __HIP_MEMORY_SCOPE_AGENT) < 4u && ++spins < (1u << 22)) __builtin_amdgcn_s_sleep(2);
        }
        __builtin_amdgcn_s_barrier(); asm volatile("" ::: "memory");
        f32x4 gv[2][2];
#pragma unroll
        for (int bj = 0; bj < 2; ++bj)
#pragma unroll
            for (int n = 0; n < 2; ++n) gv[bj][n] = *(const f32x4*)(fn + col0 + bj * 128 + n * 16);
#pragma unroll
        for (int ai = 0; ai < 2; ++ai)
#pragma unroll
            for (int m = 0; m < 4; ++m) { const int row = row0 + ai * 128 + m * 16;
                const float rs = rsqrtf(__hip_atomic_load(ss + row, __ATOMIC_RELAXED, __HIP_MEMORY_SCOPE_AGENT) * (1.0f / D) + EPS);
#pragma unroll
                for (int bj = 0; bj < 2; ++bj)
#pragma unroll
                    for (int n = 0; n < 2; ++n) *(f32x4*)(out + (size_t)row * D + col0 + bj * 128 + n * 16) = acc[ai][bj][m][n] * rs * gv[bj][n]; }
    }
};
struct EpiProj {
    static constexpr bool PERM = true, AFTER_DRAIN = false;
    bf16* P; const float* ss;
    __device__ __forceinline__ void operator()(const f32x4 (&acc)[2][2][4][2], const Unit& u, int wr, int wc, int fr, int fq) const {
        const int row0 = u.pm * 256 + wr * 64 + fr, col0 = u.pn * 256 + wc * 32 + 8 * fq; const int act = u.pn < 4 ? 1 : (u.pn < 10 ? 0 : 2);
#pragma unroll
        for (int ai = 0; ai < 2; ++ai)
#pragma unroll
            for (int m = 0; m < 4; ++m) {
                const int row = row0 + ai * 128 + m * 16; const float rs = rsqrtf(ss[row] * (1.0f / D) + EPS);
#pragma unroll
                for (int bj = 0; bj < 2; ++bj) {
                    float hv[8];
#pragma unroll
                    for (int n = 0; n < 2; ++n)
#pragma unroll
                        for (int q = 0; q < 4; q += 2) { float v0 = acc[ai][bj][m][n][q] * rs, v1 = acc[ai][bj][m][n][q + 1] * rs;
                            if (act != 0) { float z0 = v0, z1 = v1; if (act == 1) { z0 = 1.5957691216057308f * (v0 + 0.044715f * v0 * v0 * v0); z1 = 1.5957691216057308f * (v1 + 0.044715f * v1 * v1 * v1); }
                                float s0, s1; sigm2(z0, z1, s0, s1); v0 *= s0; v1 *= s1; }
                            hv[4 * n + q] = v0; hv[4 * n + q + 1] = v1; }
                    v4u w; w.x = pk2(hv[0], hv[1]); w.y = pk2(hv[2], hv[3]); w.z = pk2(hv[4], hv[5]); w.w = pk2(hv[6], hv[7]);
                    *(v4u*)(P + (size_t)row * NIN + col0 + bj * 128) = w;
                }
            }
    }
};

struct Args { const float* in[21]; float* out; unsigned char* ws; int ph_lo, ph_hi; };

__device__ __forceinline__ void transpose_item(const float* W, int ldn, int K, const float* gain, bf16* WT, int k0, int n0, int dst_row0, LAS float* scr, int lane) {
    float tv[32];
#pragma unroll
    for (int i = 0; i < 32; ++i) tv[i] = __builtin_nontemporal_load(W + (size_t)(k0 + 2 * i + (lane >> 5)) * ldn + n0 + (lane & 31));
#pragma unroll
    for (int i = 0; i < 32; ++i) { const int kk = 2 * i + (lane >> 5); float v = tv[i]; if (gain) v *= gain[k0 + kk]; scr[kk * 33 + (lane & 31)] = v; }
    LDS_WAIT(); asm volatile("" ::: "memory");
    const int c = lane & 7;
#pragma unroll
    for (int j = 0; j < 4; ++j) { const int n = (lane >> 3) + 8 * j; const LAS float* s = scr + (8 * c) * 33 + n;
        v4u o; o.x = pk2(s[0 * 33], s[1 * 33]); o.y = pk2(s[2 * 33], s[3 * 33]); o.z = pk2(s[4 * 33], s[5 * 33]); o.w = pk2(s[6 * 33], s[7 * 33]);
        *(v4u*)(WT + (size_t)(dst_row0 + n) * K + k0 + 8 * c) = o; }
    LDS_WAIT(); asm volatile("" ::: "memory");
}
__device__ __forceinline__ void p0_prologue(const Args& a, LAS unsigned char* lds, int wave, int lane, int grp, int gw, int NGW) {
    unsigned char* ws = a.ws;
    LAS float* scr = (LAS float*)(lds + wave * 16384);
    constexpr int I_GU = (D / 64) * (FF / 32), I_DN = (FF / 64) * (D / 32), I_IN = (D / 64) * (NIN / 32), I_OUT = (D / 64) * (D / 32);
    constexpr int NITEMS = 4 * I_GU + 2 * I_DN + I_IN + I_OUT;
    for (int it = gw; it < NITEMS; it += NGW) {
        int r = it;
        if (r < 4 * I_GU) {
            const int which = r / I_GU; r -= which * I_GU; if ((which >= 2 ? 2 : 0) != grp) continue; const int nblk = FF / 32, kb = r / nblk, nb = r % nblk, n0 = 32 * nb;
            const float* W = a.in[which == 0 ? 2 : which == 1 ? 3 : which == 2 ? 17 : 18]; const float* gn = a.in[which < 2 ? 1 : 16];
            bf16* WT = (bf16*)(ws + (which < 2 ? WS_WGU1 : WS_WGU2));
            const int dst = 256 * (n0 / 128) + (n0 % 128) + ((which & 1) ? 128 : 0);
            transpose_item(W, FF, D, gn, WT, 64 * kb, n0, dst, scr, lane); continue; }
        r -= 4 * I_GU;
        if (r < 2 * I_DN) { const int which = r / I_DN; r -= which * I_DN; if ((which == 1 ? 2 : 1) != grp) continue; const int nblk = D / 32, kb = r / nblk, nb = r % nblk;
            transpose_item(a.in[which ? 19 : 4], D, FF, nullptr, (bf16*)(ws + (which ? WS_WD2 : WS_WD1)), 64 * kb, 32 * nb, 32 * nb, scr, lane); continue; }
        r -= 2 * I_DN;
        if (r < I_IN) { if (grp != 1) continue; const int nblk = NIN / 32, kb = r / nblk, nb = r % nblk;
            transpose_item(a.in[6], DIN, D, a.in[5], (bf16*)(ws + WS_WIN), 64 * kb, 32 * nb, 32 * nb, scr, lane); continue; }
        r -= I_IN;
        if (grp == 2) { const int nblk = D / 32, kb = r / nblk, nb = r % nblk;
            transpose_item(a.in[15], D, D, nullptr, (bf16*)(ws + WS_WOUT), 64 * kb, 32 * nb, 32 * nb, scr, lane); }
    }
    if (grp != 0) return;
    { float* wex = (float*)(ws + WS_WEX); const int gt = blockIdx.x * NTHR + threadIdx.x;
      if (gt < 8 * D) { const int j = gt / D, k = gt % D; wex[gt] = a.in[6][(size_t)k * DIN + NIN + j] * a.in[5][k]; } }
    { const float* x = a.in[0]; bf16* xb = (bf16*)(ws + WS_XB); float* ss1 = (float*)(ws + WS_CTL);
      for (int m0 = gw * 8; m0 < M; m0 += NGW * 8) {
          f32x4 v[8][4];
#pragma unroll
          for (int r8 = 0; r8 < 8; ++r8) { const f32x4* xr = (const f32x4*)(x + (size_t)(m0 + r8) * D) + lane;
#pragma unroll
              for (int j = 0; j < 4; ++j) v[r8][j] = __builtin_nontemporal_load(xr + 64 * j); }
#pragma unroll
          for (int r8 = 0; r8 < 8; ++r8) { float sq = 0.f;
#pragma unroll
              for (int j = 0; j < 4; ++j) sq += (v[r8][j][0] * v[r8][j][0] + v[r8][j][1] * v[r8][j][1]) + (v[r8][j][2] * v[r8][j][2] + v[r8][j][3] * v[r8][j][3]);
              sq = wave_sum(sq);
              v2u* o8 = (v2u*)(xb + (size_t)(m0 + r8) * D) + lane;
#pragma unroll
              for (int j = 0; j < 4; ++j) { v2u w; w.x = pk2(v[r8][j][0], v[r8][j][1]); w.y = pk2(v[r8][j][2], v[r8][j][3]); o8[64 * j] = w; }
              if (lane == 0) ss1[m0 + r8] = sq; }
      } }
}

__device__ __forceinline__ void pex_rows(unsigned char* ws, int wave, int lane) {
    const bf16* xb = (const bf16*)(ws + WS_XB); const float* wex = (const float*)(ws + WS_WEX); const float* ss2 = (const float*)(ws + WS_CTL) + M; float* pex = (float*)(ws + WS_PEX);
    const int gw = blockIdx.x * NWAVES + wave, NGW = gridDim.x * NWAVES;
    unsigned wq[8][8];
#pragma unroll
    for (int j = 0; j < 8; ++j)
#pragma unroll
        for (int q = 0; q < 4; ++q) { const f32x4 w = *(const f32x4*)(wex + j * D + 16 * lane + 4 * q); wq[j][2 * q] = pk2(w[0], w[1]); wq[j][2 * q + 1] = pk2(w[2], w[3]); }
    for (int m = gw; m < M; m += NGW) {
        const v4u* xr = (const v4u*)(xb + (size_t)m * D + 16 * lane); const v4u a0 = xr[0], a1 = xr[1];
        const unsigned xw[8] = { a0.x, a0.y, a0.z, a0.w, a1.x, a1.y, a1.z, a1.w };
        float sj[8];
#pragma unroll
        for (int j = 0; j < 8; ++j) { float s = 0.f;
#pragma unroll
            for (int q = 0; q < 8; ++q) s += lo_bf(xw[q]) * lo_bf(wq[j][q]) + hi_bf(xw[q]) * hi_bf(wq[j][q]);
            sj[j] = s; }
        float t4[4], t2[2], t1;
#pragma unroll
        for (int q = 0; q < 4; ++q) { const bool up = lane & 1; const float keep = up ? sj[2 * q + 1] : sj[2 * q], give = up ? sj[2 * q] : sj[2 * q + 1]; t4[q] = keep + __shfl_xor(give, 1); }
#pragma unroll
        for (int q = 0; q < 2; ++q) { const bool up = lane & 2; const float keep = up ? t4[2 * q + 1] : t4[2 * q], give = up ? t4[2 * q] : t4[2 * q + 1]; t2[q] = keep + __shfl_xor(give, 2); }
        { const bool up = lane & 4; const float keep = up ? t2[1] : t2[0], give = up ? t2[0] : t2[1]; t1 = keep + __shfl_xor(give, 4); }
        t1 += __shfl_xor(t1, 8); t1 += __shfl_xor(t1, 16); t1 += __shfl_xor(t1, 32);
        if (lane < 8) pex[(size_t)m * 8 + lane] = t1 * rsqrtf(ss2[m] * (1.0f / D) + EPS);
    }
}

__device__ __forceinline__ void gmlp_item(const Args& a, LAS unsigned char* lds, int it2, int tid, int wave, int lane) {
    const int it = it2 >> 1, half = it2 & 1;
    unsigned char* ws = a.ws; const bf16* P = (const bf16*)(ws + WS_H); bf16* Y = (bf16*)(ws + WS_Y);
    const float* lng = a.in[7]; const float* lnb = a.in[8]; const float* Ws = a.in[9]; const float* bs = a.in[10];
    const int r0 = it * 128;
    constexpr int VS = 272;
    LAS unsigned char* vnT = lds;
    LAS float* stat = (LAS float*)(lds + 256 * VS);
    { v4u vv[16];
#pragma unroll
      for (int t = 0; t < 16; ++t) vv[t] = *(const v4u*)(P + (size_t)(r0 + wave * 16 + t) * NIN + 512 + 8 * lane);
#pragma unroll
      for (int t = 0; t < 16; ++t) { const v4u v = vv[t];
        const float f[8] = { lo_bf(v.x), hi_bf(v.x), lo_bf(v.y), hi_bf(v.y), lo_bf(v.z), hi_bf(v.z), lo_bf(v.w), hi_bf(v.w) };
        float s1 = 0.f, s2 = 0.f;
#pragma unroll
        for (int q = 0; q < 8; ++q) { s1 += f[q]; s2 += f[q] * f[q]; }
        s1 = wave_sum(s1); s2 = wave_sum(s2);
        const float mean = s1 * (1.0f / 512.0f), var = fmaxf(s2 * (1.0f / 512.0f) - mean * mean, 0.f);
        if (lane == 0) { stat[2 * (wave * 16 + t)] = mean; stat[2 * (wave * 16 + t) + 1] = rsqrtf(var + EPS); } } }
    WG_BAR();
    {
#pragma unroll 2
        for (int r = 0; r < 8; ++r) { const int task = tid + NTHR * r, j = task & 127, cgp = task >> 7, c0 = 256 * half + 8 * cgp;
            const v4u v = *(const v4u*)(P + (size_t)(r0 + j) * NIN + 512 + c0);
            const float f[8] = { lo_bf(v.x), hi_bf(v.x), lo_bf(v.y), hi_bf(v.y), lo_bf(v.z), hi_bf(v.z), lo_bf(v.w), hi_bf(v.w) };
            const float mean = stat[2 * j], rs = stat[2 * j + 1];
#pragma unroll
            for (int q = 0; q < 8; ++q) { const float o = (f[q] - mean) * rs * lng[c0 + q] + lnb[c0 + q];
                *(LAS unsigned short*)(vnT + (8 * cgp + q) * VS + 2 * j) = (unsigned short)(pk2(o, 0.f) & 0xffffu); }
        }
        WG_BAR();
        const int ti = wave >> 1, tc = wave & 1, rr = lane & 31, hh = lane >> 5;
        for (int gl = 0; gl < 4; ++gl) { const int g = 4 * half + gl;
            f32x16 acc = zero16();
            const float* Wg = Ws + (size_t)g * 128 * 128 + (size_t)(32 * ti + rr) * 128 + 8 * hh;
            const LAS unsigned char* bp = vnT + (64 * gl + 32 * tc + rr) * VS + 16 * hh;
            const int nks = ti < 2 ? 4 : 8;
            bf16x8 av[8];
#pragma unroll
            for (int ks = 0; ks < 8; ++ks) if (ks < nks) {
                const f32x4 w0 = *(const f32x4*)(Wg + 16 * ks), w1 = *(const f32x4*)(Wg + 16 * ks + 4);
                v4u aw; aw.x = pk2(w0[0], w0[1]); aw.y = pk2(w0[2], w0[3]); aw.z = pk2(w1[0], w1[1]); aw.w = pk2(w1[2], w1[3]);
                av[ks] = __builtin_bit_cast(bf16x8, aw); }
#pragma unroll
            for (int ks = 0; ks < 8; ++ks) if (ks < nks) {
                const bf16x8 bv = *(const LAS bf16x8*)(bp + 32 * ks);
                acc = __builtin_amdgcn_mfma_f32_32x32x16_bf16(bv, av[ks], acc, 0, 0, 0);
            }
            const int i = 32 * ti + rr; const float bias = bs[g * 128 + i];
            const bf16* up = P + (size_t)(r0 + i) * NIN + 64 * g + 32 * tc + 4 * hh; bf16* yp = Y + (size_t)(r0 + i) * D + 64 * g + 32 * tc + 4 * hh;
            v2u uv[4];
#pragma unroll
            for (int g4 = 0; g4 < 4; ++g4) uv[g4] = *(const v2u*)(up + 8 * g4);
#pragma unroll
            for (int g4 = 0; g4 < 4; ++g4) { v2u w; w.x = pk2(lo_bf(uv[g4].x) * (acc[4 * g4] + bias), hi_bf(uv[g4].x) * (acc[4 * g4 + 1] + bias)); w.y = pk2(lo_bf(uv[g4].y) * (acc[4 * g4 + 2] + bias), hi_bf(uv[g4].y) * (acc[4 * g4 + 3] + bias));
                *(v2u*)(yp + 8 * g4) = w; }
        }
        WG_BAR();
    }
}


template <int J> __device__ __forceinline__ void fmac_rowbcast(float& acc, int l, float xv) { asm("v_fmac_f32_dpp %0, %1, %2 row_newbcast:%3 row_mask:0xf bank_mask:0xf" : "+v"(acc) : "v"(l), "v"(xv), "n"(J)); }
__device__ __forceinline__ void fmac_rowbcast_sel(float& acc, int l, float xv, int j) {
    switch (j & 15) { case 0: fmac_rowbcast<0>(acc, l, xv); break; case 1: fmac_rowbcast<1>(acc, l, xv); break; case 2: fmac_rowbcast<2>(acc, l, xv); break; case 3: fmac_rowbcast<3>(acc, l, xv); break;
        case 4: fmac_rowbcast<4>(acc, l, xv); break; case 5: fmac_rowbcast<5>(acc, l, xv); break; case 6: fmac_rowbcast<6>(acc, l, xv); break; case 7: fmac_rowbcast<7>(acc, l, xv); break;
        case 8: fmac_rowbcast<8>(acc, l, xv); break; case 9: fmac_rowbcast<9>(acc, l, xv); break; case 10: fmac_rowbcast<10>(acc, l, xv); break; case 11: fmac_rowbcast<11>(acc, l, xv); break;
        case 12: fmac_rowbcast<12>(acc, l, xv); break; case 13: fmac_rowbcast<13>(acc, l, xv); break; case 14: fmac_rowbcast<14>(acc, l, xv); break; default: fmac_rowbcast<15>(acc, l, xv); break; }
}

constexpr int KS_ = 272, AS_ = 144;
constexpr int L_KH = 0, L_QS = L_KH + 64 * KS_, L_LM = L_QS + 64 * KS_, L_AT = L_LM + 64 * 272, L_SOL = L_AT + 64 * AS_, L_KDT = L_SOL + 256 * AS_, L_V = L_KDT + 128 * AS_, L_GC = L_V + 64 * KS_, L_BETA = L_GC + 256, L_BK = L_BETA + 256, L_CW = L_BK + 256, L_END = L_CW + 3 * 4 * 128 * 4;
static_assert(L_END <= LDS_BYTES, "prep LDS");
__device__ __forceinline__ void dn_prep_item(const Args& a, LAS unsigned char* lds, int item, int tid, int wave, int lane, int& cwh, int next_item) {
    unsigned char* ws = a.ws; const bf16* P = (const bf16*)(ws + WS_H); bf16* Y = (bf16*)(ws + WS_Y);
    const float* cw = a.in[11]; const float* pex = (const float*)(ws + WS_PEX);
    const int h = item & 3, n = (item >> 2) & (NCH - 1), b = item >> 9; const int tok0 = b * T + n * 64;
    LAS float* cwl = (LAS float*)(lds + L_CW);
    if (h != cwh) { cwh = h;
        for (int idx = tid; idx < 1536; idx += NTHR) { const int which = idx >> 9, jj = (idx >> 7) & 3, c = idx & 127; cwl[idx] = cw[jj * 1536 + which * 512 + h * 128 + c]; } }
    LAS float* gcs = (LAS float*)(lds + L_GC); LAS float* betas = (LAS float*)(lds + L_BETA); LAS float* bks = (LAS float*)(lds + L_BK); LAS float* Lm = (LAS float*)(lds + L_LM);
    if (wave == 0) {
        const float araw = pex[(size_t)(tok0 + lane) * 8 + 4 + h], braw = pex[(size_t)(tok0 + lane) * 8 + h];
        const float xx = araw + a.in[13][h]; const float sp = fmaxf(xx, 0.f) + __logf(1.f + __expf(-fabsf(xx)));
        float g = -__expf(a.in[12][h]) * sp;
#pragma unroll
        for (int o = 1; o < 64; o <<= 1) { const float t = __shfl_up(g, o); if (lane >= o) g += t; }
        const float be = sigm(braw); gcs[lane] = g; betas[lane] = be; bks[lane] = be * __expf(g);
    }
    WG_BAR();
#pragma unroll 3
    for (int r = 0; r < 6; ++r) { const int task = tid + NTHR * r, which = task >> 10, i = (task & 1023) >> 4, gq = task & 15;
        const int col = 1024 + which * 512 + h * 128 + 8 * gq;
        v4u xv[4];
#pragma unroll
        for (int jj = 0; jj < 4; ++jj) { const int pos = n * 64 + i - 3 + jj; xv[jj] = (v4u){0u, 0u, 0u, 0u};
            if (pos >= 0) xv[jj] = *(const v4u*)(P + (size_t)(b * T + pos) * NIN + col); }
        float o[8];
#pragma unroll
        for (int q = 0; q < 8; ++q) o[q] = 0.f;
#pragma unroll
        for (int jj = 0; jj < 4; ++jj) { const v4u v = xv[jj];
            const f32x4 w0 = *(const LAS f32x4*)(cwl + (which * 4 + jj) * 128 + 8 * gq), w1 = *(const LAS f32x4*)(cwl + (which * 4 + jj) * 128 + 8 * gq + 4);
            o[0] += w0[0] * lo_bf(v.x); o[1] += w0[1] * hi_bf(v.x); o[2] += w0[2] * lo_bf(v.y); o[3] += w0[3] * hi_bf(v.y);
            o[4] += w1[0] * lo_bf(v.z); o[5] += w1[1] * hi_bf(v.z); o[6] += w1[2] * lo_bf(v.w); o[7] += w1[3] * hi_bf(v.w); }
        float s = 0.f;
#pragma unroll
        for (int q = 0; q < 8; ++q) { o[q] = silu_(o[q]); s += o[q] * o[q]; }
        s += __shfl_xor(s, 1); s += __shfl_xor(s, 2); s += __shfl_xor(s, 4); s += __shfl_xor(s, 8);
        const float inv = which == 2 ? 1.0f : rsqrtf(s + EPS) * (which == 0 ? 0.08838834764831845f : 1.0f);
        v4u w; w.x = pk2(o[0] * inv, o[1] * inv); w.y = pk2(o[2] * inv, o[3] * inv); w.z = pk2(o[4] * inv, o[5] * inv); w.w = pk2(o[6] * inv, o[7] * inv);
        *(LAS v4u*)(lds + (which == 0 ? L_QS : which == 1 ? L_KH : L_V) + i * KS_ + 16 * gq) = w;
    }
    WG_BAR();
    { const int ti = wave & 1, tj = (wave >> 1) & 1, isq = wave >> 2, rr = lane & 31, hh = lane >> 5;
      f32x16 acc = zero16();
      if (!(ti == 0 && tj == 1)) mm_lds<8>(acc, lds + (isq ? L_QS : L_KH) + 32 * ti * KS_, KS_, lds + L_KH + 32 * tj * KS_, KS_, lane);
      const int j = 32 * tj + rr; const float gj = gcs[j];
#pragma unroll
      for (int r = 0; r < 16; ++r) { const int i = 32 * ti + (r & 3) + 8 * (r >> 2) + 4 * hh;
          const float dec = __expf(fminf(gcs[i] - gj, 0.f));
          if (isq) { const float v = (i >= j) ? acc[r] * dec : 0.f; *(LAS unsigned short*)(lds + L_AT + i * AS_ + 2 * j) = (unsigned short)(pk2(v, 0.f) & 0xffffu); }
          else { Lm[i * 68 + j] = (i > j) ? -(betas[i] * acc[r] * dec) : 0.f; } }
    }
    WG_BAR();
    if (wave < 4) {
        float x[64];
        { const LAS unsigned char* src = lds + (tid < 128 ? L_V : L_KH) + 2 * (tid & 127); const LAS float* fac = tid < 128 ? betas : bks;
#pragma unroll
          for (int i = 0; i < 64; ++i) x[i] = bf2f(*(const LAS unsigned short*)(src + i * KS_)) * fac[i]; }
        { const LAS float* lrow = Lm + (lane & 15);
#pragma unroll
        for (int i = 1; i < 64; ++i) { float sa[4] = { x[i], 0.f, 0.f, 0.f };
            int lr[4];
#pragma unroll
            for (int g = 0; g < (i + 15) / 16; ++g) lr[g] = __float_as_int(lrow[i * 68 + 16 * g]);
#pragma unroll
            for (int j = 0; j < i; ++j) { fmac_rowbcast_sel(sa[j & 3], lr[j >> 4], x[j], j); }
            x[i] = (sa[0] + sa[1]) + (sa[2] + sa[3]); } }
#pragma unroll
        for (int q = 0; q < 8; ++q) { v4u w; w.x = pk2(x[8 * q], x[8 * q + 1]); w.y = pk2(x[8 * q + 2], x[8 * q + 3]); w.z = pk2(x[8 * q + 4], x[8 * q + 5]); w.w = pk2(x[8 * q + 6], x[8 * q + 7]);
            *(LAS v4u*)(lds + L_SOL + tid * AS_ + 16 * q) = w; }
    } else {
        const int t2 = tid - 256; const float gl = gcs[63];
#pragma unroll 4
        for (int r = 0; r < 32; ++r) { const int idx = t2 + 256 * r, i = idx & 63, d = idx >> 6;
            const float v = bf2f(*(const LAS unsigned short*)(lds + L_KH + i * KS_ + 2 * d)) * __expf(gl - gcs[i]);
            *(LAS unsigned short*)(lds + L_KDT + d * AS_ + 2 * i) = (unsigned short)(pk2(v, 0.f) & 0xffffu); }
        if (next_item >= 0) { const int h2 = next_item & 3, n2 = (next_item >> 2) & (NCH - 1), b2 = next_item >> 9; unsigned d0 = 0u, d1 = 0u;
            const unsigned char* pb = (const unsigned char*)(P + (size_t)(b2 * T + n2 * 64) * NIN + 1024 + h2 * 128);
            { const int idx = t2, row = idx / 6, seg = idx % 6; if (n2 > 0 || row >= 3) asm volatile("global_load_dword %0, %1, off" : "+v"(d0) : "v"(pb + (ptrdiff_t)(row - 3) * (NIN * 2) + (seg >> 1) * 1024 + (seg & 1) * 128) : "memory"); }
            { const int idx = t2 + 256, row = idx / 6, seg = idx % 6; if (idx < 402) asm volatile("global_load_dword %0, %1, off" : "+v"(d1) : "v"(pb + (ptrdiff_t)(row - 3) * (NIN * 2) + (seg >> 1) * 1024 + (seg & 1) * 128) : "memory"); }
            asm volatile("s_waitcnt vmcnt(0)" ::: "memory"); asm volatile("" :: "v"(d0), "v"(d1)); }
    }
    WG_BAR();
    { const int rr = lane & 31, hh = lane >> 5;
      bf16* Ms = (bf16*)(ws + WS_MS) + (size_t)item * 16384; bf16* Bs = (bf16*)(ws + WS_BS) + (size_t)item * 16384; bf16* Qp = (bf16*)(ws + WS_QP) + (size_t)item * 8192;
#pragma unroll 1
      for (int tt = 0; tt < 2; ++tt) { const int tile = 2 * wave + tt, tdp = tile >> 2, td = tile & 3;
          f32x16 acc = zero16(); mm_lds<4>(acc, lds + L_SOL + (128 + 32 * tdp) * AS_, AS_, lds + L_KDT + 32 * td * AS_, AS_, lane);
#pragma unroll
          for (int r = 0; r < 16; ++r) acc[r] = -acc[r];
          ans_store(Ms + (td * 4 + tdp) * 1024, acc, lane); }
#pragma unroll 1
      for (int tt = 0; tt < 2; ++tt) { const int tile = 2 * wave + tt, td = tile >> 2, te = tile & 3;
          f32x16 acc = zero16(); mm_lds<4>(acc, lds + L_KDT + 32 * td * AS_, AS_, lds + L_SOL + 32 * te * AS_, AS_, lane);
          ans_store(Bs + (te * 4 + td) * 1024, acc, lane); }
      { const int td = wave >> 1, ti = wave & 1;
          f32x16 acc = zero16(); mm_lds<4>(acc, lds + L_SOL + (128 + 32 * td) * AS_, AS_, lds + L_AT + 32 * ti * AS_, AS_, lane);
          const int i = 32 * ti + rr; const float eg = __expf(gcs[i]);
#pragma unroll
          for (int g = 0; g < 4; ++g) { const v2u qv = *(const LAS v2u*)(lds + L_QS + i * KS_ + 2 * (32 * td + 8 * g + 4 * hh));
              acc[4 * g] = lo_bf(qv.x) * eg - acc[4 * g]; acc[4 * g + 1] = hi_bf(qv.x) * eg - acc[4 * g + 1]; acc[4 * g + 2] = lo_bf(qv.y) * eg - acc[4 * g + 2]; acc[4 * g + 3] = hi_bf(qv.y) * eg - acc[4 * g + 3]; }
          ans_store(Qp + (ti * 4 + td) * 1024, acc, lane); }
      { const int ti = wave & 1, te = wave >> 1;
          f32x16 acc = zero16(); mm_lds<4>(acc, lds + L_AT + 32 * ti * AS_, AS_, lds + L_SOL + 32 * te * AS_, AS_, lane);
          v4u w0, w1; ans_pack(acc, w0, w1); const int eo = (ti * 4 + te) * 1024 + lane * 8;
          *(v4u*)yslot(Y, tok0, h, eo) = w0; *(v4u*)yslot(Y, tok0, h, eo + 512) = w1; }
      if (tid == 0) ((float*)(ws + WS_GL))[item] = __expf(gcs[63]);
    }
    WG_BAR();
}

constexpr int SC_RING = 16384, SC_SLOT = 32768;
struct ScanB { v4u bn[2]; float egl; };
__device__ __forceinline__ int scan_item(int bh, int n) { if (n > NCH - 1) n = NCH - 1; return ((bh >> 2) * NCH + n) * 4 + (bh & 3); }
__device__ __forceinline__ void scanb_load(ScanB& p, const unsigned char* ws, int bh, int n, int td, int te, int lane) {
    const int item = scan_item(bh, n);
    p.egl = ((const float*)(ws + WS_GL))[item];
    const bf16* Bs = (const bf16*)(ws + WS_BS) + (size_t)item * 16384 + (te * 4 + td) * 1024 + lane * 8;
    p.bn[0] = *(const v4u*)Bs; p.bn[1] = *(const v4u*)(Bs + 512);
}
__device__ __forceinline__ void scan_step(const ScanB& p, f32x16& acc, unsigned char* ws, LAS unsigned char* lds, int bh, int n, int cur, int td, int te, int lane) {
    const int item = scan_item(bh, n);
    v4u b0 = p.bn[0], b1 = p.bn[1]; float egl = p.egl;
    asm volatile("" : "+v"(egl)); asm volatile("" : "+v"(b0)); asm volatile("" : "+v"(b1));
    f32x16 bv16; ans_unpack(b0, b1, bv16);
#pragma unroll
    for (int r = 0; r < 16; ++r) acc[r] = acc[r] * egl + bv16[r];
    const LAS unsigned char* sb = lds + cur * 8192 + lane * 16;
    const LAS unsigned char* sa = lds + SC_RING + (n & 3) * SC_SLOT + td * 8192 + lane * 16;
    f32x16 acc2 = zero16();
#pragma unroll
    for (int q = 0; q < 8; q += 2) {
        const bf16x8 a0 = *(const LAS bf16x8*)(sa + 1024 * q), bv0 = *(const LAS bf16x8*)(sb + 1024 * q);
        const bf16x8 a1 = *(const LAS bf16x8*)(sa + 1024 * (q + 1)), bv1 = *(const LAS bf16x8*)(sb + 1024 * (q + 1));
        acc = __builtin_amdgcn_mfma_f32_32x32x16_bf16(a0, bv0, acc, 0, 0, 0); acc2 = __builtin_amdgcn_mfma_f32_32x32x16_bf16(a1, bv1, acc2, 0, 0, 0); }
#pragma unroll
    for (int r = 0; r < 16; ++r) acc[r] += acc2[r];
    v4u w0, w1; ans_pack(acc, w0, w1);
    LAS unsigned char* sn = lds + (cur ^ 1) * 8192 + td * 2048 + lane * 16;
    *(LAS v4u*)sn = w0; *(LAS v4u*)(sn + 1024) = w1;
    bf16* So = (bf16*)(ws + WS_BS) + (size_t)item * 16384 + (te * 4 + td) * 1024 + lane * 8;
    *(v4u*)So = w0; *(v4u*)(So + 512) = w1;
}
struct ScanA { bf16x8 a[8]; };
__device__ __forceinline__ void scana_load(ScanA& p, const unsigned char* ws, int bh, int n, int td, int lane) {
    const bf16* Ms = (const bf16*)(ws + WS_MS) + (size_t)scan_item(bh, n) * 16384 + td * 4096 + lane * 8;
#pragma unroll
    for (int q = 0; q < 8; ++q) p.a[q] = *(const bf16x8*)(Ms + 512 * q);
}
__device__ __forceinline__ void scana_put(const ScanA& p, LAS unsigned char* lds, int n, int td, int lane) {
    LAS unsigned char* d = lds + SC_RING + (n & 3) * SC_SLOT + td * 8192 + lane * 16;
#pragma unroll
    for (int q = 0; q < 8; ++q) *(LAS bf16x8*)(d + 1024 * q) = p.a[q];
}
__device__ __forceinline__ void dn_scan(const Args& a, LAS unsigned char* lds, int wg, int tid, int wave, int lane) {
    unsigned char* ws = a.ws;
    const int bh = wg & 7, te = wg >> 3, td = wave & 3;
    for (int u = tid; u < 2 * 8192 / 4; u += NTHR) ((LAS unsigned*)lds)[u] = 0u;
    if (wave < 4) {
        f32x16 acc = zero16();
        ScanB p0, p1, p2, p3, p4, p5, p6, p7;
        scanb_load(p0, ws, bh, 0, td, te, lane); scanb_load(p1, ws, bh, 1, td, te, lane); scanb_load(p2, ws, bh, 2, td, te, lane); scanb_load(p3, ws, bh, 3, td, te, lane);
        scanb_load(p4, ws, bh, 4, td, te, lane); scanb_load(p5, ws, bh, 5, td, te, lane); scanb_load(p6, ws, bh, 6, td, te, lane);
        WG_BAR();
#pragma unroll 1
        for (int n = 0; n < NCH; n += 8) {
            scanb_load(p7, ws, bh, n + 7, td, te, lane);  scan_step(p0, acc, ws, lds, bh, n, 0, td, te, lane); WG_BAR();
            scanb_load(p0, ws, bh, n + 8, td, te, lane);  scan_step(p1, acc, ws, lds, bh, n + 1, 1, td, te, lane); WG_BAR();
            scanb_load(p1, ws, bh, n + 9, td, te, lane);  scan_step(p2, acc, ws, lds, bh, n + 2, 0, td, te, lane); WG_BAR();
            scanb_load(p2, ws, bh, n + 10, td, te, lane); scan_step(p3, acc, ws, lds, bh, n + 3, 1, td, te, lane); WG_BAR();
            scanb_load(p3, ws, bh, n + 11, td, te, lane); scan_step(p4, acc, ws, lds, bh, n + 4, 0, td, te, lane); WG_BAR();
            scanb_load(p4, ws, bh, n + 12, td, te, lane); scan_step(p5, acc, ws, lds, bh, n + 5, 1, td, te, lane); WG_BAR();
            scanb_load(p5, ws, bh, n + 13, td, te, lane); scan_step(p6, acc, ws, lds, bh, n + 6, 0, td, te, lane); WG_BAR();
            scanb_load(p6, ws, bh, n + 14, td, te, lane); scan_step(p7, acc, ws, lds, bh, n + 7, 1, td, te, lane); WG_BAR();
        }
    } else {
        ScanA s0, s1, s2, s3;
        scana_load(s0, ws, bh, 0, td, lane); scana_load(s1, ws, bh, 1, td, lane); scana_load(s2, ws, bh, 2, td, lane);
        scana_put(s0, lds, 0, td, lane); scana_put(s1, lds, 1, td, lane); scana_put(s2, lds, 2, td, lane);
        scana_load(s3, ws, bh, 3, td, lane); scana_load(s0, ws, bh, 4, td, lane); scana_load(s1, ws, bh, 5, td, lane); scana_load(s2, ws, bh, 6, td, lane);
        WG_BAR();
#pragma unroll 1
        for (int n = 0; n < NCH; n += 4) {
            scana_put(s3, lds, n + 3, td, lane); scana_load(s3, ws, bh, n + 7, td, lane); WG_BAR();
            scana_put(s0, lds, n + 4, td, lane); scana_load(s0, ws, bh, n + 8, td, lane); WG_BAR();
            scana_put(s1, lds, n + 5, td, lane); scana_load(s1, ws, bh, n + 9, td, lane); WG_BAR();
            scana_put(s2, lds, n + 6, td, lane); scana_load(s2, ws, bh, n + 10, td, lane); WG_BAR();
        }
    }
}


__device__ __forceinline__ int dn_item_of(int c, int k, int G) {
    if ((G & 7) != 0 || NCH % (G >> 3) != 0) { const int it = c + k * G; return it < NITEM ? it : -1; }
    const int bh = c & 7, n = (c >> 3) + (G >> 3) * k; return n < NCH ? ((bh >> 2) * NCH + n) * 4 + (bh & 3) : -1;
}

struct OutPre { v4u o0, o1, z0, z1; bf16x8 av[8], bv[8]; };
__device__ __forceinline__ void out_load(OutPre& p, const Args& a, int item, int tid, int wave, int lane) {
    const unsigned char* ws = a.ws; const bf16* P = (const bf16*)(ws + WS_H); bf16* Y = (bf16*)(ws + WS_Y);
    const int h = item & 3, n = (item >> 2) & (NCH - 1), b = item >> 9; const int tok0 = b * T + n * 64;
    const int ti = wave & 1, te = wave >> 1;
    const v4u* zp = (const v4u*)(P + (size_t)(tok0 + (tid >> 3)) * NIN + 2560 + 128 * h + 16 * (tid & 7)); p.z0 = zp[0]; p.z1 = zp[1];
    { const int eo = (ti * 4 + te) * 1024 + lane * 8; p.o0 = *(const v4u*)yslot(Y, tok0, h, eo); p.o1 = *(const v4u*)yslot(Y, tok0, h, eo + 512); }
    if (n > 0) {
        const bf16* Qp = (const bf16*)(ws + WS_QP) + (size_t)item * 8192 + ti * 4096 + lane * 8;
        const bf16* Sp = (const bf16*)(ws + WS_BS) + (size_t)(item - 4) * 16384 + te * 4096 + lane * 8;
#pragma unroll
        for (int q = 0; q < 8; ++q) { p.av[q] = *(const bf16x8*)(Qp + 512 * q); p.bv[q] = *(const bf16x8*)(Sp + 512 * q); }
    }
}
__device__ __forceinline__ void dn_out_phase(const Args& a, LAS unsigned char* lds, int c, int G, int tid, int wave, int lane) {
    unsigned char* ws = a.ws; bf16* Y = (bf16*)(ws + WS_Y);
    int item = dn_item_of(c, 0, G); if (item < 0) return;
    OutPre p; out_load(p, a, item, tid, wave, lane);
    const int ti = wave & 1, te = wave >> 1, rr = lane & 31, hh = lane >> 5, e = 32 * te + rr;
    LAS float* of = (LAS float*)lds;
#pragma unroll 1
    for (int k = 0; item >= 0; ++k) {
        const int h = item & 3, n = (item >> 2) & (NCH - 1), b = item >> 9; const int tok0 = b * T + n * 64;
        const int nx = dn_item_of(c, k + 1, G);
        f32x16 acc; ans_unpack(p.o0, p.o1, acc);
        if (n > 0) {
#pragma unroll
            for (int q = 0; q < 8; ++q) acc = __builtin_amdgcn_mfma_f32_32x32x16_bf16(p.av[q], p.bv[q], acc, 0, 0, 0);
        }
        const v4u z0 = p.z0, z1 = p.z1;
        if (nx >= 0) out_load(p, a, nx, tid, wave, lane);
#pragma unroll
        for (int r = 0; r < 16; ++r) { const int i = 32 * ti + (r & 3) + 8 * (r >> 2) + 4 * hh; of[i * 132 + e] = acc[r]; }
        WG_BAR();
        { const int i = tid >> 3, e0 = 16 * (tid & 7);
          float v[16]; float sq = 0.f;
#pragma unroll
          for (int q = 0; q < 4; ++q) { const f32x4 t = *(const LAS f32x4*)(of + i * 132 + e0 + 4 * q); v[4 * q] = t[0]; v[4 * q + 1] = t[1]; v[4 * q + 2] = t[2]; v[4 * q + 3] = t[3]; sq += (t[0] * t[0] + t[1] * t[1]) + (t[2] * t[2] + t[3] * t[3]); }
          sq += __shfl_xor(sq, 1); sq += __shfl_xor(sq, 2); sq += __shfl_xor(sq, 4);
          const float rs = rsqrtf(sq * (1.0f / 128.0f) + EPS);
          const float zz[16] = { lo_bf(z0.x), hi_bf(z0.x), lo_bf(z0.y), hi_bf(z0.y), lo_bf(z0.z), hi_bf(z0.z), lo_bf(z0.w), hi_bf(z0.w), lo_bf(z1.x), hi_bf(z1.x), lo_bf(z1.y), hi_bf(z1.y), lo_bf(z1.z), hi_bf(z1.z), lo_bf(z1.w), hi_bf(z1.w) };
          const float* dw = a.in[14] + e0; float o[16];
#pragma unroll
          for (int q = 0; q < 16; ++q) o[q] = v[q] * rs * dw[q] * zz[q];
          v4u w0, w1; w0.x = pk2(o[0], o[1]); w0.y = pk2(o[2], o[3]); w0.z = pk2(o[4], o[5]); w0.w = pk2(o[6], o[7]); w1.x = pk2(o[8], o[9]); w1.y = pk2(o[10], o[11]); w1.z = pk2(o[12], o[13]); w1.w = pk2(o[14], o[15]);
          v4u* yp = (v4u*)(Y + (size_t)(tok0 + i) * D + 512 + 128 * h + e0); yp[0] = w0; yp[1] = w1; }
        WG_BAR();
        item = nx;
    }
}

constexpr int NPHASE = 10;
__global__ void __launch_bounds__(NTHR, 2) fwd_kernel(Args args) {
    extern __shared__ __attribute__((aligned(16))) unsigned char lds_raw[];
    LAS unsigned char* lds = (LAS unsigned char*)lds_raw;
    const int tid = threadIdx.x, lane = tid & 63, wave = __builtin_amdgcn_readfirstlane(tid >> 6);
    unsigned char* ws = args.ws; const int G = gridDim.x;
    const int lo = args.ph_lo, hi = args.ph_hi;
    float* ss = (float*)(ws + WS_CTL);
    bf16* XB = (bf16*)(ws + WS_XB); bf16* HB = (bf16*)(ws + WS_H); bf16* YB = (bf16*)(ws + WS_Y);
#define IN(k) (lo <= (k) && (k) < hi)
    volatile LAS unsigned* bst = (volatile LAS unsigned*)(lds + LDS_BYTES - 64);
    if (tid < 2) bst[tid] = 0u;
    __syncthreads();
    const XcdBarrier bar = xcd_barrier_post((unsigned*)(ws + WS_BAR), bst);
    if (lo < -1) cg::this_grid().sync();
#define SEAM(k) do { if (IN(k) && IN((k) + 1)) xcd_barrier(bar); } while (0)
    if (IN(0)) { p0_prologue(args, lds, wave, lane, 0, blockIdx.x * NWAVES + wave, G * NWAVES); }
    SEAM(0);
    if (IN(1)) { pg8::Gemm g{XB, (const bf16*)(ws + WS_WGU1), M, 2 * FF, D}; pg8::StaticOrder S; S.init(M, 2 * FF, G, (int)blockIdx.x);
        EpiSwiglu E{HB, ss}; pg8::gemm_phase<EpiSwiglu, pg8::StaticOrder, true, true>(lds, g, S, E);
        { const int nfull = (M / 256) * (2 * FF / 256) % G; if (nfull != 0 && (int)blockIdx.x >= nfull) p0_prologue(args, lds, wave, lane, 1, ((int)blockIdx.x - nfull) * NWAVES + wave, (G - nfull) * NWAVES);
          else if (nfull == 0) p0_prologue(args, lds, wave, lane, 1, blockIdx.x * NWAVES + wave, G * NWAVES); } }
    SEAM(1);
    if (IN(2)) { pg8::Gemm g{HB, (const bf16*)(ws + WS_WD1), M, D, FF}; pg8::StaticOrder S; S.init(M, D, G, (int)blockIdx.x);
        EpiResid E{args.in[0], args.out, XB, ss + M, 0.5f}; pg8::gemm_phase<EpiResid, pg8::StaticOrder, true, true>(lds, g, S, E); }
    SEAM(2);
    if (IN(3)) { pg8::Gemm g{XB, (const bf16*)(ws + WS_WIN), M, NIN, D}; pg8::StaticOrder S; S.init(M, NIN, G, (int)blockIdx.x);
        EpiProj E{HB, ss + M}; pg8::gemm_phase<EpiProj, pg8::StaticOrder, true, true>(lds, g, S, E);
        pex_rows(ws, wave, lane); }
    SEAM(3);
    if (IN(4)) { int cwh = -1; for (int k = 0, it = dn_item_of(blockIdx.x, 0, G); it >= 0; ++k) { const int nx = dn_item_of(blockIdx.x, k + 1, G); dn_prep_item(args, lds, it, tid, wave, lane, cwh, nx); it = nx; } }
    SEAM(4);
    if (IN(5)) {
        if (blockIdx.x < 32) dn_scan(args, lds, blockIdx.x, tid, wave, lane);
        else { const int c = blockIdx.x - 32, NC = G - 32;
            for (int it = c; it < M / 64; it += NC) gmlp_item(args, lds, it, tid, wave, lane);
            const int nd = M / 64 - NC;
            if (c >= nd) p0_prologue(args, lds, wave, lane, 2, (c - nd) * NWAVES + wave, (NC - nd) * NWAVES); } }
    SEAM(5);
    if (IN(6)) { dn_out_phase(args, lds, blockIdx.x, G, tid, wave, lane); }
    SEAM(6);
    if (IN(7)) { pg8::Gemm g{YB, (const bf16*)(ws + WS_WOUT), M, D, D}; pg8::StaticOrder S; S.init(M, D, G, (int)blockIdx.x);
        EpiResid E{args.out, args.out, XB, ss + 2 * M, 1.0f}; pg8::gemm_phase<EpiResid, pg8::StaticOrder, true, true>(lds, g, S, E); }
    SEAM(7);
    if (IN(8)) { pg8::Gemm g{XB, (const bf16*)(ws + WS_WGU2), M, 2 * FF, D}; pg8::StaticOrder S; S.init(M, 2 * FF, G, (int)blockIdx.x);
        EpiSwiglu E{HB, ss + 2 * M}; pg8::gemm_phase<EpiSwiglu, pg8::StaticOrder, true, true>(lds, g, S, E); }
    SEAM(8);
    if (IN(9)) { pg8::Gemm g{HB, (const bf16*)(ws + WS_WD2), M, D, FF}; pg8::StaticOrder S; S.init(M, D, G, (int)blockIdx.x);
        EpiFinal E{args.out, args.out, ss + 3 * M, (unsigned*)(ws + WS_PCNT), args.in[20], 0.5f}; pg8::gemm_phase<EpiFinal, pg8::StaticOrder, true, true>(lds, g, S, E); }
#undef IN
#undef SEAM
}

#ifndef MK_ONE_LAUNCH
#define MK_ONE_LAUNCH 1
#endif
extern "C" void kernel_launch(void* const* d_in, const int* in_sizes, int n_in, void* d_out, int out_size, void* d_ws, size_t ws_size, hipStream_t stream) {
    static int grid = 0;
    if (grid == 0) {
        if (n_in != 21 || out_size != M * D || ws_size < WS_END) { fprintf(stderr, "kernel_launch: unexpected shapes (n_in %d out %d ws %zu)\n", n_in, out_size, ws_size); grid = -1; return; }
        if (hipFuncSetAttribute((const void*)fwd_kernel, hipFuncAttributeMaxDynamicSharedMemorySize, LDS_BYTES) != hipSuccess) { fprintf(stderr, "kernel_launch: hipFuncSetAttribute failed\n"); grid = -1; return; }
        int dev = 0, cus = 0, per_cu = 0; hipGetDevice(&dev); hipDeviceGetAttribute(&cus, hipDeviceAttributeMultiprocessorCount, dev);
        hipOccupancyMaxActiveBlocksPerMultiprocessor(&per_cu, (const void*)fwd_kernel, NTHR, LDS_BYTES);
        if (per_cu < 1) { fprintf(stderr, "kernel_launch: occupancy query says %d blocks per CU\n", per_cu); per_cu = 1; }
        (void)hipGetLastError();
        grid = cus;
    }
    if (grid < 0) return;
    hipMemsetAsync((char*)d_ws + WS_CTL, 0, CTL_ZERO_BYTES, stream);
    Args a{};
    for (int i = 0; i < 21; ++i) a.in[i] = (const float*)d_in[i];
    a.out = (float*)d_out; a.ws = (unsigned char*)d_ws;
#if MK_ONE_LAUNCH
    a.ph_lo = 0; a.ph_hi = NPHASE;
    void* kargs[] = { &a };
    hipError_t e = hipLaunchCooperativeKernel((const void*)fwd_kernel, dim3(grid), dim3(NTHR), kargs, LDS_BYTES, stream);
    if (e != hipSuccess) fprintf(stderr, "cooperative launch failed: %s (grid %d)\n", hipGetErrorString(e), grid);
#else
    for (int p = 0; p < NPHASE; ++p) { a.ph_lo = p; a.ph_hi = p + 1; hipLaunchKernelGGL(fwd_kernel, dim3(grid), dim3(NTHR), LDS_BYTES, stream, a); }
#endif
}
```
